# Optimizing an MI355X kernel written in HIP

```python
import math
import jax, jax.numpy as jnp
from jax import lax
import numpy as np

D_MODEL = 1024
BATCH = 2
SEQ = 8192
DEPTH = 4

N_MIXERS = 2
N_S5_LAYERS = (DEPTH + 1) // 2
N_ATTN_LAYERS = DEPTH // 2
N_META = 16
GRID_W = 64
HEAD_DIM = 64
N_Q_HEADS = D_MODEL // HEAD_DIM
N_KV_HEADS = N_Q_HEADS // 4
Q_PER_KV = N_Q_HEADS // N_KV_HEADS
QKV_WIDTH = (N_Q_HEADS + 2 * N_KV_HEADS) * HEAD_DIM
QUERY_BLOCK = 128
ROPE_THETA = 10000.0
ROPE_AXIS_DIM = HEAD_DIM // 2
QK_EPS = 1e-6
S5_GROUP_CH = 16
S5_GROUPS = D_MODEL // S5_GROUP_CH
S5_STATE = 64
S5_DT_MIN = 1e-3
S5_DT_MAX = 1e-1
D_FF = -(-8 * D_MODEL // (3 * 256)) * 256
LN_EPS = 1e-5
DEEPNORM_ALPHA = (2.0 * DEPTH) ** 0.25
DEEPNORM_BETA = (8.0 * DEPTH) ** -0.25

kernel_name = "hybrid_s5_gqa_deepnorm_encoder"


def layer_norm(x, gain, bias):
    xf = x.astype(jnp.float32)
    mean = jnp.mean(xf, axis=-1, keepdims=True)
    var = jnp.mean(jnp.square(xf - mean), axis=-1, keepdims=True)
    y = (xf - mean) * lax.rsqrt(var + LN_EPS) * gain.astype(jnp.float32) + bias.astype(jnp.float32)
    return y.astype(x.dtype)


def swiglu_ffn(h, w_gate, w_up, w_down):
    return (jax.nn.silu(h @ w_gate) * (h @ w_up)) @ w_down


def _s5_combine(left, right):
    ar1, ai1, br1, bi1 = left
    ar2, ai2, br2, bi2 = right
    ar = ar1 * ar2 - ai1 * ai2
    ai = ar1 * ai2 + ai1 * ar2
    br = ar2 * br1 - ai2 * bi1 + br2
    bi = ar2 * bi1 + ai2 * br1 + bi2
    return (ar, ai, br, bi)


def s5_direction(u, lam_re, lam_im, log_dt, b_re, b_im, c_re, c_im, reverse):
    L = u.shape[1]
    lr = lam_re.astype(jnp.float32)
    li = lam_im.astype(jnp.float32)
    dt = jnp.exp(log_dt.astype(jnp.float32))[:, None]
    mag = jnp.exp(lr * dt)
    abr = mag * jnp.cos(li * dt)
    abi = mag * jnp.sin(li * dt)
    nr, ni = abr - 1.0, abi
    den = lr * lr + li * li
    cr = (nr * lr + ni * li) / den
    ci = (ni * lr - nr * li) / den
    br = b_re.astype(jnp.float32)
    bi = b_im.astype(jnp.float32)
    bbr = cr[..., None] * br - ci[..., None] * bi
    bbi = cr[..., None] * bi + ci[..., None] * br
    bu_r = jnp.einsum('blgc,gpc->blgp', u, bbr)
    bu_i = jnp.einsum('blgc,gpc->blgp', u, bbi)
    a_r = jnp.broadcast_to(abr[None, None], (1, L) + abr.shape)
    a_i = jnp.broadcast_to(abi[None, None], (1, L) + abi.shape)
    _, _, sr, si = lax.associative_scan(_s5_combine, (a_r, a_i, bu_r, bu_i),
                                        reverse=reverse, axis=1)
    return (jnp.einsum('blgp,gcp->blgc', sr, c_re.astype(jnp.float32))
            - jnp.einsum('blgp,gcp->blgc', si, c_im.astype(jnp.float32)))


def s5_mixer(h, lam_re, lam_im, log_dt, b_re, b_im, c_re, c_im, d_skip, w_glu, w_out):
    bsz, L, _ = h.shape
    hf = h.astype(jnp.float32)
    u = hf.reshape(bsz, L, S5_GROUPS, S5_GROUP_CH)
    y = (s5_direction(u, lam_re[0], lam_im[0], log_dt[0], b_re[0], b_im[0], c_re[0], c_im[0], False)
         + s5_direction(u, lam_re[1], lam_im[1], log_dt[1], b_re[1], b_im[1], c_re[1], c_im[1], True))
    y = y.reshape(bsz, L, D_MODEL) + d_skip.astype(jnp.float32) * hf
    g = jax.nn.gelu(y, approximate=False).astype(h.dtype)
    z = g * jax.nn.sigmoid(g @ w_glu)
    return z @ w_out


def axial_rope_tables(n_real):
    rows = n_real // GRID_W
    row_ids = jnp.repeat(jnp.arange(rows, dtype=jnp.int32), GRID_W)
    col_ids = jnp.tile(jnp.arange(GRID_W, dtype=jnp.int32), rows)
    pad = jnp.zeros((N_META,), jnp.int32)
    row_ids = jnp.concatenate([pad, row_ids]).astype(jnp.float32)
    col_ids = jnp.concatenate([pad, col_ids]).astype(jnp.float32)
    inv_freq = ROPE_THETA ** (-jnp.arange(0, ROPE_AXIS_DIM, 2, dtype=jnp.float32) / ROPE_AXIS_DIM)
    ang_r = row_ids[:, None] * inv_freq[None, :]
    ang_c = col_ids[:, None] * inv_freq[None, :]
    return jnp.cos(ang_r), jnp.sin(ang_r), jnp.cos(ang_c), jnp.sin(ang_c)


def _rotate_half_block(xh, cos, sin):
    half = ROPE_AXIS_DIM // 2
    x1, x2 = xh[..., :half], xh[..., half:]
    c = cos[None, :, None, :]
    s = sin[None, :, None, :]
    return jnp.concatenate([x1 * c - x2 * s, x2 * c + x1 * s], axis=-1)


def rms_axial_rope(t, gain, cos_r, sin_r, cos_c, sin_c):
    tf = t.astype(jnp.float32)
    tf = tf * lax.rsqrt(jnp.mean(jnp.square(tf), axis=-1, keepdims=True) + QK_EPS) * gain.astype(jnp.float32)
    return jnp.concatenate([_rotate_half_block(tf[..., :ROPE_AXIS_DIM], cos_r, sin_r),
                            _rotate_half_block(tf[..., ROPE_AXIS_DIM:], cos_c, sin_c)], axis=-1)


def _attend(q, k, v):
    s = jnp.einsum('bqkgd,bskd->bkgqs', q, k).astype(jnp.float32) * (HEAD_DIM ** -0.5)
    p = jax.nn.softmax(s, axis=-1).astype(v.dtype)
    return jnp.einsum('bkgqs,bskd->bqkgd', p, v)


def gqa_mixer(h, w_qkv, q_gain, k_gain, w_out, cos_r, sin_r, cos_c, sin_c):
    bsz, L, _ = h.shape
    qkv = h @ w_qkv
    nq, nk = N_Q_HEADS * HEAD_DIM, N_KV_HEADS * HEAD_DIM
    q = qkv[..., :nq].reshape(bsz, L, N_Q_HEADS, HEAD_DIM)
    k = qkv[..., nq:nq + nk].reshape(bsz, L, N_KV_HEADS, HEAD_DIM)
    v = qkv[..., nq + nk:].reshape(bsz, L, N_KV_HEADS, HEAD_DIM)
    q = rms_axial_rope(q, q_gain, cos_r, sin_r, cos_c, sin_c).astype(v.dtype)
    k = rms_axial_rope(k, k_gain, cos_r, sin_r, cos_c, sin_c).astype(v.dtype)
    q = q.reshape(bsz, L, N_KV_HEADS, Q_PER_KV, HEAD_DIM)
    out_meta = _attend(q[:, :N_META], k, v)
    n_real = L - N_META
    n_blk = n_real // QUERY_BLOCK
    qb = q[:, N_META:].reshape(bsz, n_blk, QUERY_BLOCK, N_KV_HEADS, Q_PER_KV, HEAD_DIM).swapaxes(0, 1)
    out_real = lax.map(lambda blk: _attend(blk, k, v), qb)
    out_real = out_real.swapaxes(0, 1).reshape(bsz, n_real, N_KV_HEADS, Q_PER_KV, HEAD_DIM)
    out = jnp.concatenate([out_meta, out_real], axis=1).reshape(bsz, L, D_MODEL)
    return out @ w_out


def setup_inputs(seed: int = 0) -> dict:
    key = jax.random.key(seed)
    ks = jax.random.split(key, 24)
    f32 = jnp.float32
    D, G, P, C = D_MODEL, S5_GROUPS, S5_STATE, S5_GROUP_CH
    nS, nA = N_S5_LAYERS, N_ATTN_LAYERS
    x = jax.random.normal(ks[0], (BATCH, SEQ, D), f32)
    meta_tokens = jax.random.normal(ks[1], (N_META, D), f32)
    s5_lambda_re = -0.5 * jnp.exp(0.02 * jax.random.normal(ks[2], (nS, 2, G, P), f32))
    s5_lambda_im = (math.pi * jnp.arange(P, dtype=f32))[None, None, None, :] \
        + 0.01 * jax.random.normal(ks[3], (nS, 2, G, P), f32)
    s5_log_dt = jax.random.uniform(ks[4], (nS, 2, G), f32,
                                   minval=math.log(S5_DT_MIN), maxval=math.log(S5_DT_MAX))
    b_scale = (2.0 * C) ** -0.5
    s5_b_re = jax.random.normal(ks[5], (nS, 2, G, P, C), f32) * b_scale
    s5_b_im = jax.random.normal(ks[6], (nS, 2, G, P, C), f32) * b_scale
    c_scale = (2.0 * P) ** -0.5
    s5_c_re = jax.random.normal(ks[7], (nS, 2, G, C, P), f32) * c_scale
    s5_c_im = jax.random.normal(ks[8], (nS, 2, G, C, P), f32) * c_scale
    s5_d = jax.random.normal(ks[9], (nS, D), f32)
    s5_w_glu = jax.random.normal(ks[10], (nS, D, D), f32) * D ** -0.5
    s5_w_out = jax.random.normal(ks[11], (nS, D, D), f32) * (D ** -0.5 * DEEPNORM_BETA)
    w_qk = jax.random.normal(ks[12], (nA, D, (N_Q_HEADS + N_KV_HEADS) * HEAD_DIM), f32) * D ** -0.5
    w_v = jax.random.normal(ks[13], (nA, D, N_KV_HEADS * HEAD_DIM), f32) * (D ** -0.5 * DEEPNORM_BETA)
    attn_w_qkv = jnp.concatenate([w_qk, w_v], axis=-1)
    attn_q_gain = 1.0 + 0.02 * jax.random.normal(ks[14], (nA, HEAD_DIM), f32)
    attn_k_gain = 1.0 + 0.02 * jax.random.normal(ks[15], (nA, HEAD_DIM), f32)
    attn_w_out = jax.random.normal(ks[16], (nA, D, D), f32) * (D ** -0.5 * DEEPNORM_BETA)
    ffn_w_gate = jax.random.normal(ks[17], (DEPTH, D, D_FF), f32) * D ** -0.5
    ffn_w_up = jax.random.normal(ks[18], (DEPTH, D, D_FF), f32) * D ** -0.5
    ffn_w_down = jax.random.normal(ks[19], (DEPTH, D_FF, D), f32) * (D_FF ** -0.5 * DEEPNORM_BETA)
    ln_gain = 1.0 + 0.02 * jax.random.normal(ks[20], (DEPTH, 2, D), f32)
    ln_bias = 0.02 * jax.random.normal(ks[21], (DEPTH, 2, D), f32)
    return {"x": x, "meta_tokens": meta_tokens,
            "s5_lambda_re": s5_lambda_re, "s5_lambda_im": s5_lambda_im, "s5_log_dt": s5_log_dt,
            "s5_b_re": s5_b_re, "s5_b_im": s5_b_im, "s5_c_re": s5_c_re, "s5_c_im": s5_c_im,
            "s5_d": s5_d, "s5_w_glu": s5_w_glu, "s5_w_out": s5_w_out,
            "attn_w_qkv": attn_w_qkv, "attn_q_gain": attn_q_gain, "attn_k_gain": attn_k_gain,
            "attn_w_out": attn_w_out,
            "ffn_w_gate": ffn_w_gate, "ffn_w_up": ffn_w_up, "ffn_w_down": ffn_w_down,
            "ln_gain": ln_gain, "ln_bias": ln_bias}


def reference(x, meta_tokens, s5_lambda_re, s5_lambda_im, s5_log_dt, s5_b_re, s5_b_im,
              s5_c_re, s5_c_im, s5_d, s5_w_glu, s5_w_out, attn_w_qkv, attn_q_gain,
              attn_k_gain, attn_w_out, ffn_w_gate, ffn_w_up, ffn_w_down, ln_gain, ln_bias):
    bsz, n_real, d = x.shape
    meta = jnp.broadcast_to(meta_tokens.astype(x.dtype)[None], (bsz, N_META, d))
    h = jnp.concatenate([meta, x], axis=1)
    cos_r, sin_r, cos_c, sin_c = axial_rope_tables(n_real)
    for i in range(DEPTH):
        j = i // N_MIXERS
        if i % N_MIXERS == 0:
            mix = s5_mixer(h, s5_lambda_re[j], s5_lambda_im[j], s5_log_dt[j], s5_b_re[j], s5_b_im[j],
                           s5_c_re[j], s5_c_im[j], s5_d[j], s5_w_glu[j], s5_w_out[j])
        else:
            mix = gqa_mixer(h, attn_w_qkv[j], attn_q_gain[j], attn_k_gain[j], attn_w_out[j],
                            cos_r, sin_r, cos_c, sin_c)
        h = layer_norm(DEEPNORM_ALPHA * h + mix, ln_gain[i, 0], ln_bias[i, 0])
        h = layer_norm(DEEPNORM_ALPHA * h + swiglu_ffn(h, ffn_w_gate[i], ffn_w_up[i], ffn_w_down[i]),
                       ln_gain[i, 1], ln_bias[i, 1])
    return h[:, N_META:]
```

```cpp
#include <hip/hip_runtime.h>
#include <hip/hip_cooperative_groups.h>
#include <cstdio>
#include <cstdint>
namespace pg8 {
#define PG8_LAS __attribute__((address_space(3)))
typedef unsigned short bf16_t;
typedef short bf16x8 __attribute__((ext_vector_type(8)));
typedef float f32x4 __attribute__((ext_vector_type(4)));
typedef unsigned u32x4 __attribute__((ext_vector_type(4)));
constexpr int BM = 256, BK = 64, HALF = 128, HTB = HALF * BK * 2  , STAGE_BYTES = 8 * HTB, NXCD = 8, WGM = 8;

__host__ __device__ __forceinline__ int lds_byte(int r, int c) { const int st = (r >> 4) * 2 + (c >> 5), rr = r & 15, cc = c & 31, ob = rr * 64 + cc * 2; return st * 1024 + (ob ^ (((ob >> 9) & 1) << 5)); }
__host__ __device__ __forceinline__ void stage_rc(int b, int& R, int& C) { const int st = b / 1024, sb = b % 1024, swz = sb ^ (((sb >> 9) & 1) << 5); R = (st >> 1) * 16 + swz / 64; C = (st & 1) * 32 + (swz % 64) / 2; }
__host__ __device__ __forceinline__ int perm32(int rho) { const int n = rho >> 4, i = rho & 15; return 8 * (i >> 2) + 4 * n + (i & 3); }

struct Unit { int pm, pn; long aoff, boff; };
struct Gemm { const bf16_t* A; const bf16_t* Bt; int M, N, K, lda; };

struct StaticOrder {
    int nM, nN, nwg, G, c; long astep, bstep;
    __host__ __device__ void init(int M, int N, int K, int lda, int G_, int c_) { nM = M / BM; nN = N / BM; nwg = nM * nN; G = G_; c = c_; astep = (long)BM * lda * 2; bstep = (long)BM * K * 2; }
    __host__ __device__ bool next(int i, Unit& u) const {
        const long L = (long)i * G + c; if (L >= nwg) return false;
        int wgid = (int)L; { const int q = nwg / NXCD, r = nwg % NXCD, xcd = wgid % NXCD, off = wgid / NXCD; wgid = (xcd < r ? xcd * (q + 1) : r * (q + 1) + (xcd - r) * q) + off; }
        const int nig = WGM * nN, gid = wgid / nig, fm = gid * WGM, gsz = (nM - fm) < WGM ? (nM - fm) : WGM;
        u.pm = fm + ((wgid % nig) % gsz); u.pn = (wgid % nig) / gsz; u.aoff = u.pm * astep; u.boff = u.pn * bstep; return true;
    }
    __device__ __forceinline__ void a_ready(const Unit&) const {}
    __device__ __forceinline__ void done(const Unit&) const {}
};

__device__ __forceinline__ unsigned cvt_pk_bf16(float lo, float hi) { unsigned r; asm volatile("v_cvt_pk_bf16_f32 %0, %1, %2" : "=v"(r) : "v"(lo), "v"(hi)); return r; }
typedef float f32x2 __attribute__((ext_vector_type(2)));
__device__ __forceinline__ f32x2 gelu_pk(f32x2 v) {
    const f32x2 av = __builtin_elementwise_abs(v), d = av * 0.2316418882f + 1.0f;
    f32x2 t; t.x = __builtin_amdgcn_rcpf(d.x); t.y = __builtin_amdgcn_rcpf(d.y);
    f32x2 q = t * 0.5307027145f + (-0.7265760135f); q = q * t + 0.7107068705f; q = q * t + (-0.142248368f); q = q * t + 0.127414796f; q = q * t;
    const f32x2 s = (v * v) * (-0.72134752044f);
    f32x2 e; e.x = __builtin_amdgcn_exp2f(s.x); e.y = __builtin_amdgcn_exp2f(s.y);
    const f32x2 m = v * (q * e), r = v - m;
    f32x2 o; o.x = v.x < 0.f ? m.x : r.x; o.y = v.y < 0.f ? m.y : r.y; return o;
}

template <int ACT  > struct EpiBf16 {
    static constexpr bool PERM = true, AFTER_DRAIN = false; static_assert(ACT == 0 || ACT == 1, "EpiBf16: ACT is 0 (none) or 1 (gelu_pk)");
    bf16_t* O; int ldc; const float* bias; int split_cols; size_t split_stride; float scale0;
    __device__ __forceinline__ void operator()(const f32x4 (&acc)[2][2][4][2], const Unit& u, int wr, int wc, int fr, int fq) const {
        const int row0 = u.pm * BM + wr * 64 + fr; int colt = u.pn * BM; bf16_t* base = O;
        float sc = 1.f; if (split_cols) { const int t = colt / split_cols; base += (size_t)t * split_stride; colt -= t * split_cols; if (t == 0) sc = scale0; }
        const int col0 = colt + wc * 32 + 8 * fq, bcol0 = u.pn * BM + wc * 32 + 8 * fq;
        f32x4 bv[2][2];
#pragma unroll
        for (int bj = 0; bj < 2; ++bj)
#pragma unroll
            for (int n = 0; n < 2; ++n) bv[bj][n] = bias ? *(const f32x4*)(bias + bcol0 + bj * HALF + 4 * n) : (f32x4){0.f, 0.f, 0.f, 0.f};
#pragma unroll
        for (int ai = 0; ai < 2; ++ai)
#pragma unroll
            for (int m = 0; m < 4; ++m) { bf16_t* rowp = base + (size_t)(row0 + ai * HALF + m * 16) * ldc + col0;
#pragma unroll
                for (int bj = 0; bj < 2; ++bj) { f32x4 v0 = acc[ai][bj][m][0] + bv[bj][0], v1 = acc[ai][bj][m][1] + bv[bj][1];
                    if (ACT == 1) { f32x2 a = gelu_pk((f32x2){v0[0], v0[1]}), b = gelu_pk((f32x2){v0[2], v0[3]}), c = gelu_pk((f32x2){v1[0], v1[1]}), d = gelu_pk((f32x2){v1[2], v1[3]});
                        v0 = (f32x4){a.x, a.y, b.x, b.y}; v1 = (f32x4){c.x, c.y, d.x, d.y}; }
                    v0 = v0 * sc; v1 = v1 * sc; u32x4 w; w.x = cvt_pk_bf16(v0[0], v0[1]); w.y = cvt_pk_bf16(v0[2], v0[3]); w.z = cvt_pk_bf16(v1[0], v1[1]); w.w = cvt_pk_bf16(v1[2], v1[3]);
                    *(u32x4*)(rowp + bj * HALF) = w; } }
    }
};
constexpr int MREAL = 16384;
typedef unsigned u32x2e __attribute__((ext_vector_type(2)));
__device__ __forceinline__ float bf_lo(unsigned w) { return __uint_as_float(w << 16); }
__device__ __forceinline__ float bf_hi(unsigned w) { return __uint_as_float(w & 0xffff0000u); }
__device__ __forceinline__ float sigmoid_f(float x) { return __builtin_amdgcn_rcpf(1.f + __builtin_amdgcn_exp2f(-1.4426950408889634f * x)); }
struct EpiRes {
    static constexpr bool PERM = false, AFTER_DRAIN = false;
    float* hreal; float* hmeta; float alpha;
    __device__ __forceinline__ void operator()(const f32x4 (&acc)[2][2][4][2], const Unit& u, int wr, int wc, int fr, int fq) const {
        float* base = (u.pm < MREAL / BM) ? hreal + (size_t)u.pm * BM * 1024 : hmeta + (size_t)(u.pm - MREAL / BM) * BM * 1024;
        const int col0 = u.pn * BM + wc * 32 + 4 * fq;
#pragma unroll
        for (int ai = 0; ai < 2; ++ai)
#pragma unroll
            for (int m = 0; m < 4; ++m) { float* rowp = base + (size_t)(ai * HALF + wr * 64 + m * 16 + fr) * 1024 + col0;
#pragma unroll
                for (int bj = 0; bj < 2; ++bj)
#pragma unroll
                    for (int n = 0; n < 2; ++n) { f32x4* p = (f32x4*)(rowp + bj * HALF + n * 16); const f32x4 hv = *p; *p = hv * alpha + acc[ai][bj][m][n]; } }
    }
};
struct EpiGlu {
    static constexpr bool PERM = true, AFTER_DRAIN = false;
    const bf16_t* Gb; bf16_t* Z;
    __device__ __forceinline__ void operator()(const f32x4 (&acc)[2][2][4][2], const Unit& u, int wr, int wc, int fr, int fq) const {
        const int row0 = u.pm * BM + wr * 64 + fr, col0 = u.pn * BM + wc * 32 + 8 * fq;
#pragma unroll
        for (int ai = 0; ai < 2; ++ai)
#pragma unroll
            for (int m = 0; m < 4; ++m) { const size_t off = (size_t)(row0 + ai * HALF + m * 16) * 1024 + col0;
#pragma unroll
                for (int bj = 0; bj < 2; ++bj) { const u32x4 gv = *(const u32x4*)(Gb + off + bj * HALF); const f32x4 a0 = acc[ai][bj][m][0], a1 = acc[ai][bj][m][1]; u32x4 w;
                    w.x = cvt_pk_bf16(bf_lo(gv.x) * sigmoid_f(a0[0]), bf_hi(gv.x) * sigmoid_f(a0[1])); w.y = cvt_pk_bf16(bf_lo(gv.y) * sigmoid_f(a0[2]), bf_hi(gv.y) * sigmoid_f(a0[3]));
                    w.z = cvt_pk_bf16(bf_lo(gv.z) * sigmoid_f(a1[0]), bf_hi(gv.z) * sigmoid_f(a1[1])); w.w = cvt_pk_bf16(bf_lo(gv.w) * sigmoid_f(a1[2]), bf_hi(gv.w) * sigmoid_f(a1[3]));
                    *(u32x4*)(Z + off + bj * HALF) = w; } }
    }
};
struct EpiSwiGlu {
    static constexpr bool PERM = true, AFTER_DRAIN = false;
    bf16_t* FFo; int ldc;
    __device__ __forceinline__ void operator()(const f32x4 (&acc)[2][2][4][2], const Unit& u, int wr, int wc, int fr, int fq) const {
        const int row0 = u.pm * BM + wr * 64 + fr, col0 = u.pn * HALF + wc * 32 + 8 * fq;
#pragma unroll
        for (int ai = 0; ai < 2; ++ai)
#pragma unroll
            for (int m = 0; m < 4; ++m) { float o[8];
#pragma unroll
                for (int n = 0; n < 2; ++n)
#pragma unroll
                    for (int j = 0; j < 4; ++j) { const float gt = acc[ai][0][m][n][j], up = acc[ai][1][m][n][j]; o[n * 4 + j] = gt * sigmoid_f(gt) * up; }
                u32x4 w; w.x = cvt_pk_bf16(o[0], o[1]); w.y = cvt_pk_bf16(o[2], o[3]); w.z = cvt_pk_bf16(o[4], o[5]); w.w = cvt_pk_bf16(o[6], o[7]);
                *(u32x4*)(FFo + (size_t)(row0 + ai * HALF + m * 16) * ldc + col0) = w; }
    }
};
constexpr int S5_R = 1026;
struct EpiS5a {
    static constexpr bool PERM = false, AFTER_DRAIN = false;
    float* Sloc;
    __device__ __forceinline__ void operator()(const f32x4 (&acc)[2][2][4][2], const Unit& u, int wr, int wc, int fr, int fq) const {
        const int g = u.pn, rt = u.pm - 5 * g, col0 = wc * 32 + 4 * fq;
#pragma unroll
        for (int ai = 0; ai < 2; ++ai)
#pragma unroll
            for (int m = 0; m < 4; ++m) { const int rr = rt * BM + ai * HALF + wr * 64 + m * 16 + fr; if (rr < S5_R) { float* rowp = Sloc + ((size_t)g * S5_R + rr) * 256 + col0;
#pragma unroll
                for (int bj = 0; bj < 2; ++bj)
#pragma unroll
                    for (int n = 0; n < 2; ++n) *(f32x4*)(rowp + bj * HALF + n * 16) = acc[ai][bj][m][n]; } }
    }
};
struct EpiS5c {
    static constexpr bool PERM = true, AFTER_DRAIN = false;
    const float* hreal; const float* hmeta; const float* dskip; bf16_t* Gb;
    __device__ __forceinline__ void operator()(const f32x4 (&acc)[2][2][4][2], const Unit& u, int wr, int wc, int fr, int fq) const {
        const int g = u.pn, rt = u.pm - 5 * g, ch = 16 * g + 8 * (fq & 1);
        const f32x4 d0 = *(const f32x4*)(dskip + ch), d1 = *(const f32x4*)(dskip + ch + 4);
#pragma unroll
        for (int ai = 0; ai < 2; ++ai)
#pragma unroll
            for (int m = 0; m < 4; ++m) { const int rr = rt * BM + ai * HALF + wr * 64 + m * 16 + fr; if (rr < S5_R) {
#pragma unroll
                for (int bj = 0; bj < 2; ++bj) { const int t = 8 * bj + 2 * wc + (fq >> 1), tok = 16 * rr + t;
                    const float* hp = (tok < MREAL ? hreal + (size_t)tok * 1024 : hmeta + (size_t)(tok - MREAL) * 1024) + ch;
                    const f32x4 h0 = *(const f32x4*)hp, h1 = *(const f32x4*)(hp + 4);
                    const f32x4 y0 = acc[ai][bj][m][0] + d0 * h0, y1 = acc[ai][bj][m][1] + d1 * h1;
                    const f32x2 a = gelu_pk((f32x2){y0[0], y0[1]}), b = gelu_pk((f32x2){y0[2], y0[3]}), c = gelu_pk((f32x2){y1[0], y1[1]}), e = gelu_pk((f32x2){y1[2], y1[3]});
                    u32x4 w; w.x = cvt_pk_bf16(a.x, a.y); w.y = cvt_pk_bf16(b.x, b.y); w.z = cvt_pk_bf16(c.x, c.y); w.w = cvt_pk_bf16(e.x, e.y);
                    *(u32x4*)(Gb + (size_t)tok * 1024 + ch) = w; } } }
    }
};
struct S5Order {
    int G, c; long arow_bytes, brow_bytes;
    __device__ __forceinline__ bool next(int i, Unit& u) const { const int L = i * G + c; if (L >= 320) return false; const int g = L / 5, rt = L - 5 * g;
        u.pm = L; u.pn = g; u.aoff = ((long)g * S5_R + rt * BM) * arow_bytes; u.boff = (long)g * BM * brow_bytes; return true; }
    __device__ __forceinline__ void a_ready(const Unit&) const {}
    __device__ __forceinline__ void done(const Unit&) const {}
};
template <class Epi, class Sched, bool ALIGN_EPI = false, bool SP2 = false>
__device__ __forceinline__ void gemm_phase(PG8_LAS unsigned char* lds, const Gemm g, const Sched& S, const Epi& E) {
    const int tid = threadIdx.x, wid = __builtin_amdgcn_readfirstlane(tid >> 6), lane = tid & 63, wr = wid >> 2, wc = wid & 3, fr = lane & 15, fq = lane >> 4;
    const int K = g.K, nt = K / BK;
    unsigned voffA[2], voffB[2];
#pragma unroll
    for (int i = 0; i < 2; ++i) { int R, C; stage_rc(tid * 16 + i * 8192, R, C); const int Rb = Epi::PERM ? ((R & ~31) + perm32(R & 31)) : R;
        voffA[i] = (unsigned)(R * g.lda + C) * 2u; voffB[i] = (unsigned)(Rb * K + C) * 2u; }
    const size_t kstep = (size_t)(BK * 2);
    const size_t hstepA = (size_t)HALF * g.lda * 2, hstepB = (size_t)HALF * K * 2;
    const unsigned ldsw = (unsigned)wid * 1024u;
    const int aoff = lds_byte(wr * 64 + fr, fq * 8), boff = lds_byte(wc * 32 + fr, fq * 8);
#define PG8_SA(b, h) (((b) * 2 + (h)) * HTB)
#define PG8_SB(b, h) ((4 + (b) * 2 + (h)) * HTB)
#define PG8_STAGE(bufoff, gbase, voff) do { _Pragma("unroll") for (int _i = 0; _i < 2; ++_i) \
        __builtin_amdgcn_global_load_lds((const unsigned*)((const char*)(gbase) + (voff)[_i]), (PG8_LAS unsigned*)(lds + (bufoff) + ldsw + _i * 8192), 16, 0, 0); } while (0)
#define PG8_LDA(dst, b, h) do { _Pragma("unroll") for (int m = 0; m < 4; ++m) _Pragma("unroll") for (int k = 0; k < 2; ++k) dst[m][k] = *(const PG8_LAS bf16x8*)(lds + PG8_SA(b, h) + aoff + m * 2048 + k * 1024); } while (0)
#define PG8_LDB(dst, b, h) do { _Pragma("unroll") for (int n = 0; n < 2; ++n) _Pragma("unroll") for (int k = 0; k < 2; ++k) dst[n][k] = *(const PG8_LAS bf16x8*)(lds + PG8_SB(b, h) + boff + n * 2048 + k * 1024); } while (0)
#define PG8_MMA(ai, bj, At, Bt) do { __builtin_amdgcn_s_setprio(1); _Pragma("unroll") for (int m = 0; m < 4; ++m) _Pragma("unroll") for (int n = 0; n < 2; ++n) _Pragma("unroll") for (int k = 0; k < 2; ++k) \
        acc[ai][bj][m][n] = __builtin_amdgcn_mfma_f32_16x16x32_bf16(Bt[n][k], At[m][k], acc[ai][bj][m][n], 0, 0, 0); __builtin_amdgcn_s_setprio(0); } while (0)
#define PG8_WAIT_V(n) asm volatile("s_waitcnt vmcnt(" #n ")" ::: "memory")
#define PG8_WAIT_L(n) asm volatile("s_waitcnt lgkmcnt(" #n ")" ::: "memory")
#define PG8_BAR __builtin_amdgcn_s_barrier()
#define PG8_SCHED __builtin_amdgcn_sched_barrier(0)
    Unit cur, nxt; int ui = 0;
    if (!S.next(0, cur)) return;
    f32x4 acc[2][2][4][2];
#pragma unroll
    for (int a = 0; a < 2; ++a)
#pragma unroll
        for (int b = 0; b < 2; ++b)
#pragma unroll
            for (int m = 0; m < 4; ++m)
#pragma unroll
                for (int n = 0; n < 2; ++n) acc[a][b][m][n] = (f32x4){0.f, 0.f, 0.f, 0.f};
    bf16x8 At[4][2], B0[2][2], B1[2][2];
    const char* cA = (const char*)g.A + cur.aoff; const char* cB = (const char*)g.Bt + cur.boff;
    S.a_ready(cur);
    if constexpr (SP2) {
        PG8_STAGE(PG8_SB(0, 0), cB, voffB); PG8_STAGE(PG8_SB(0, 1), cB + hstepB, voffB); PG8_STAGE(PG8_SA(0, 0), cA, voffA); PG8_STAGE(PG8_SA(0, 1), cA + hstepA, voffA);
        if (wr == 1) PG8_BAR;
        PG8_WAIT_V(2); PG8_BAR;
        PG8_STAGE(PG8_SB(1, 0), cB + kstep, voffB); PG8_STAGE(PG8_SA(1, 0), cA + kstep, voffA); PG8_STAGE(PG8_SB(1, 1), cB + hstepB + kstep, voffB);
        PG8_WAIT_V(6); PG8_BAR;
    } else {
        PG8_STAGE(PG8_SB(0, 0), cB, voffB); PG8_STAGE(PG8_SA(0, 0), cA, voffA); PG8_STAGE(PG8_SB(0, 1), cB + hstepB, voffB); PG8_STAGE(PG8_SA(0, 1), cA + hstepA, voffA);
        if (wr == 1) PG8_BAR;
        PG8_WAIT_V(4); PG8_BAR;
        PG8_STAGE(PG8_SB(1, 0), cB + kstep, voffB); PG8_STAGE(PG8_SA(1, 0), cA + kstep, voffA); PG8_STAGE(PG8_SB(1, 1), cB + hstepB + kstep, voffB);
        PG8_WAIT_V(6); PG8_BAR;
    }
    for (;;) {
        const bool has_next = S.next(ui + 1, nxt);
        const char* nA = has_next ? (const char*)g.A + nxt.aoff : cA; const char* nB = has_next ? (const char*)g.Bt + nxt.boff : cB;
        for (int t = 0; t < nt; t += 2) {
            const bool last = (t == nt - 2);
            const char* a1 = cA + (size_t)(t + 1) * kstep;
            const char* a2 = last ? nA : cA + (size_t)(t + 2) * kstep; const char* b2 = last ? nB : cB + (size_t)(t + 2) * kstep;
            const char* a3 = a2 + kstep; const char* b3 = b2 + kstep;
            if (last && has_next) S.a_ready(nxt);
            if constexpr (SP2) {
            PG8_LDB(B0, 0, 0); PG8_LDB(B1, 0, 1); PG8_SCHED; PG8_LDA(At, 0, 0); PG8_STAGE(PG8_SA(1, 1), a1 + hstepA, voffA);
            PG8_WAIT_V(8); PG8_WAIT_L(0); PG8_BAR; PG8_MMA(0, 0, At, B0); PG8_MMA(0, 1, At, B1); PG8_BAR; PG8_SCHED;
            PG8_LDA(At, 0, 1); PG8_STAGE(PG8_SB(0, 0), b2, voffB); PG8_STAGE(PG8_SB(0, 1), b2 + hstepB, voffB); PG8_STAGE(PG8_SA(0, 0), a2, voffA);
            PG8_WAIT_V(8); PG8_WAIT_L(0); PG8_BAR; PG8_MMA(1, 0, At, B0); PG8_MMA(1, 1, At, B1); PG8_BAR; PG8_SCHED;
            PG8_LDB(B0, 1, 0); PG8_LDB(B1, 1, 1); PG8_SCHED; PG8_LDA(At, 1, 0); PG8_STAGE(PG8_SA(0, 1), a2 + hstepA, voffA);
            PG8_WAIT_V(8); PG8_WAIT_L(0); PG8_BAR; PG8_MMA(0, 0, At, B0); PG8_MMA(0, 1, At, B1); PG8_BAR; PG8_SCHED;
            PG8_LDA(At, 1, 1); PG8_STAGE(PG8_SB(1, 0), b3, voffB); PG8_STAGE(PG8_SB(1, 1), b3 + hstepB, voffB); PG8_STAGE(PG8_SA(1, 0), a3, voffA);
            PG8_WAIT_V(8); PG8_WAIT_L(0); PG8_BAR; PG8_MMA(1, 0, At, B0); PG8_MMA(1, 1, At, B1); PG8_BAR; PG8_SCHED;
            } else {
            PG8_LDB(B0, 0, 0); PG8_SCHED; PG8_LDA(At, 0, 0); PG8_STAGE(PG8_SA(1, 1), a1 + hstepA, voffA);
            PG8_WAIT_L(8); PG8_BAR; PG8_WAIT_L(0); PG8_MMA(0, 0, At, B0); PG8_BAR; PG8_SCHED;
            PG8_LDB(B1, 0, 1); PG8_STAGE(PG8_SB(0, 0), b2, voffB);
            PG8_BAR; PG8_WAIT_L(0); PG8_MMA(0, 1, At, B1); PG8_BAR;
            PG8_LDA(At, 0, 1); PG8_STAGE(PG8_SA(0, 0), a2, voffA);
            PG8_BAR; PG8_WAIT_L(0); PG8_MMA(1, 0, At, B0); PG8_BAR; PG8_SCHED;
            PG8_STAGE(PG8_SB(0, 1), b2 + hstepB, voffB);
            PG8_WAIT_V(6); PG8_BAR; PG8_MMA(1, 1, At, B1); PG8_BAR;
            PG8_LDB(B0, 1, 0); PG8_SCHED; PG8_LDA(At, 1, 0); PG8_STAGE(PG8_SA(0, 1), a2 + hstepA, voffA);
            PG8_WAIT_L(8); PG8_BAR; PG8_WAIT_L(0); PG8_MMA(0, 0, At, B0); PG8_BAR; PG8_SCHED;
            PG8_LDB(B1, 1, 1); PG8_STAGE(PG8_SB(1, 0), b3, voffB);
            PG8_BAR; PG8_WAIT_L(0); PG8_MMA(0, 1, At, B1); PG8_BAR;
            PG8_LDA(At, 1, 1); PG8_STAGE(PG8_SA(1, 0), a3, voffA);
            PG8_BAR; PG8_WAIT_L(0); PG8_MMA(1, 0, At, B0); PG8_BAR; PG8_SCHED;
            PG8_STAGE(PG8_SB(1, 1), b3 + hstepB, voffB);
            PG8_WAIT_V(6); PG8_BAR; PG8_MMA(1, 1, At, B1); PG8_BAR;
            }
        }
        if constexpr (ALIGN_EPI) { if (wr == 0) PG8_BAR; }
        if constexpr (!Epi::AFTER_DRAIN) { E(acc, cur, wr, wc, fr, fq); S.done(cur); }
        if (!has_next) break;
#pragma unroll
        for (int a = 0; a < 2; ++a)
#pragma unroll
            for (int b = 0; b < 2; ++b)
#pragma unroll
                for (int m = 0; m < 4; ++m)
#pragma unroll
                    for (int n = 0; n < 2; ++n) acc[a][b][m][n] = (f32x4){0.f, 0.f, 0.f, 0.f};
        cur = nxt; cA = nA; cB = nB; ++ui;
        if constexpr (ALIGN_EPI) { if (wr == 1) PG8_BAR; }
    }
    PG8_WAIT_V(0);
    if constexpr (!ALIGN_EPI) { if (wr == 0) PG8_BAR; }
    PG8_BAR;
    if constexpr (Epi::AFTER_DRAIN) { E.fused(acc, cur, wr, wc, fr, fq, lds, wid, lane); S.done(cur); }
#undef PG8_SA
#undef PG8_SB
#undef PG8_STAGE
#undef PG8_LDA
#undef PG8_LDB
#undef PG8_MMA
#undef PG8_WAIT_V
#undef PG8_WAIT_L
#undef PG8_BAR
#undef PG8_SCHED
}
}

#ifndef PG8_SP2
#define PG8_SP2 true
#endif
#ifndef PG8_ALIGN
#define PG8_ALIGN true
#endif
#include <hip/hip_bf16.h>
#include <cmath>
namespace attn_body {
using bf16=__hip_bfloat16;
using bf16x8=__attribute__((ext_vector_type(8)))short;
using s16x4=__attribute__((ext_vector_type(4)))short;
using f32x16=__attribute__((ext_vector_type(16)))float;
using u32x4=__attribute__((ext_vector_type(4)))unsigned;
constexpr int NHEAD=16,D=64,PQ=1536,PO=1024,NT=130;
constexpr int NW=8,QBLK=32,QB=QBLK*NW,KVBLK=64;
__device__ __forceinline__ int crow(int r,int hi){return (r&3)+8*(r>>2)+4*hi;}
#define SBAR() __builtin_amdgcn_sched_barrier(0)
constexpr int NSLOT=3, SLOTB=8192;
constexpr int LDS_K=0, LDS_V=NSLOT*SLOTB, LDS_WS=2*NSLOT*SLOTB, LDS_OST=LDS_WS+NW*64*4, LDS_BYTES=LDS_OST+NW*4096;
constexpr float C2=0.125f*1.4426950408889634f;
__device__ __forceinline__ void glds16(const void*gsrc,unsigned lds_dst){unsigned keep;
  asm volatile("s_mov_b32 %0, m0\n\ts_mov_b32 m0, %2\n\ts_nop 0\n\tglobal_load_lds_dwordx4 %1, off\n\ts_mov_b32 m0, %0":"=&s"(keep):"v"(gsrc),"s"(lds_dst):"memory");}
__device__ __forceinline__ float max3f(float a,float b,float c){float r;asm("v_max3_f32 %0, %1, %2, %3":"=v"(r):"v"(a),"v"(b),"v"(c));return r;}
__device__ __forceinline__ float max2f(float a,float b){float r;asm("v_max_f32_e32 %0, %1, %2":"=v"(r):"v"(a),"v"(b));return r;}
__device__ __forceinline__ float fadd_s(float a,float b){float r;asm("v_add_f32_e32 %0, %1, %2":"=v"(r):"v"(a),"v"(b));return r;}
__device__ __forceinline__ float fsub_s(float a,float b){float r;asm("v_sub_f32_e32 %0, %1, %2":"=v"(r):"v"(a),"v"(b));return r;}
typedef float f32x2_t __attribute__((ext_vector_type(2))); typedef __bf16 bf16x2_t __attribute__((ext_vector_type(2)));
__device__ __forceinline__ unsigned cvtpk_s(float lo,float hi){f32x2_t v={lo,hi};bf16x2_t b=__builtin_convertvector(v,bf16x2_t);return __builtin_bit_cast(unsigned,b);}
#define WAIT_BAR(N) asm volatile("s_waitcnt vmcnt(" #N ") lgkmcnt(0)\n\ts_barrier":::"memory")

__device__ __forceinline__ void qkt(f32x16&p0,f32x16&p1,const char*Kslot,const bf16x8*qr,const f32x16&negm,int r32,int hi){
  const char*kb=Kslot+hi*1024+r32*16;
  #pragma unroll
  for(int d0=0;d0<4;++d0){
    const bf16x8 b0=*reinterpret_cast<const bf16x8*>(kb+d0*2048);
    const bf16x8 b1=*reinterpret_cast<const bf16x8*>(kb+d0*2048+512);
    if(d0==0){p0=__builtin_amdgcn_mfma_f32_32x32x16_bf16(b0,qr[0],negm,0,0,0);p1=__builtin_amdgcn_mfma_f32_32x32x16_bf16(b1,qr[0],negm,0,0,0);}
    else{p0=__builtin_amdgcn_mfma_f32_32x32x16_bf16(b0,qr[d0],p0,0,0,0);p1=__builtin_amdgcn_mfma_f32_32x32x16_bf16(b1,qr[d0],p1,0,0,0);}}
}
typedef __attribute__((address_space(3))) const char* lds_cptr;
typedef short v4i16_t __attribute__((ext_vector_type(4)));
__device__ __forceinline__ void kload8(bf16x8*kf,lds_cptr kp){
  kf[0]=*(const __attribute__((address_space(3))) bf16x8*)(kp);      kf[1]=*(const __attribute__((address_space(3))) bf16x8*)(kp+512);
  kf[2]=*(const __attribute__((address_space(3))) bf16x8*)(kp+2048); kf[3]=*(const __attribute__((address_space(3))) bf16x8*)(kp+2560);
  kf[4]=*(const __attribute__((address_space(3))) bf16x8*)(kp+4096); kf[5]=*(const __attribute__((address_space(3))) bf16x8*)(kp+4608);
  kf[6]=*(const __attribute__((address_space(3))) bf16x8*)(kp+6144); kf[7]=*(const __attribute__((address_space(3))) bf16x8*)(kp+6656);
}
__device__ __forceinline__ void kload2(bf16x8*kf,lds_cptr kp,int j){ kf[2*j]=*(const __attribute__((address_space(3))) bf16x8*)(kp+j*2048); kf[2*j+1]=*(const __attribute__((address_space(3))) bf16x8*)(kp+j*2048+512); }
__device__ __forceinline__ s16x4 vtr(lds_cptr p){ return __builtin_bit_cast(s16x4,__builtin_amdgcn_ds_read_tr16_b64_v4i16((__attribute__((address_space(3))) v4i16_t*)p)); }
__device__ __forceinline__ float rowmax(const f32x16&p0,const f32x16&p1){
  float a=max3f(p0[0],p0[1],p1[0]),b=max3f(p0[2],p0[3],p1[1]);a=max3f(a,p1[2],p1[3]);
  #pragma unroll
  for(int r=4;r<16;r+=4){a=max3f(a,p0[r],p0[r+1]);b=max3f(b,p0[r+2],p0[r+3]);a=max3f(a,p1[r],p1[r+1]);b=max3f(b,p1[r+2],p1[r+3]);}
  const float m=max2f(a,b);
  auto rr=__builtin_amdgcn_permlane32_swap(__float_as_uint(m),__float_as_uint(m),false,false);
  return max2f(__uint_as_float(rr[0]),__uint_as_float(rr[1]));
}
__device__ __forceinline__ void pv(f32x16*o,int vb,bf16x8 pa0,bf16x8 pa1,bf16x8 pa2,bf16x8 pa3){
  #pragma unroll
  for(int d0=0;d0<2;++d0){s16x4 lo[4],hi[4];
    #pragma unroll
    for(int ks=0;ks<4;++ks){
      asm volatile("ds_read_b64_tr_b16 %0,%1 offset:%c2":"=&v"(lo[ks]):"v"(vb),"i"(d0*4096+ks*1024):"memory");
      asm volatile("ds_read_b64_tr_b16 %0,%1 offset:%c2":"=&v"(hi[ks]):"v"(vb),"i"(d0*4096+ks*1024+512):"memory");}
    asm volatile("s_waitcnt lgkmcnt(0)":::"memory");SBAR();
    #define PK(k) (bf16x8){lo[k][0],lo[k][1],lo[k][2],lo[k][3],hi[k][0],hi[k][1],hi[k][2],hi[k][3]}
    o[d0]=__builtin_amdgcn_mfma_f32_32x32x16_bf16(pa0,PK(0),o[d0],0,0,0);
    o[d0]=__builtin_amdgcn_mfma_f32_32x32x16_bf16(pa1,PK(1),o[d0],0,0,0);
    o[d0]=__builtin_amdgcn_mfma_f32_32x32x16_bf16(pa2,PK(2),o[d0],0,0,0);
    o[d0]=__builtin_amdgcn_mfma_f32_32x32x16_bf16(pa3,PK(3),o[d0],0,0,0);
    #undef PK
  }
}

#ifndef ATTN_STORE16
#define ATTN_STORE16(p,v) (*(u32x4*)(p)=(v))
#endif
__device__ __forceinline__ void tmask(f32x16&p0,f32x16&p1,bool full){ const float NEG=-INFINITY;
  #pragma unroll
  for(int r=0;r<16;++r){ p1[r]=NEG; if(full||r>=8)p0[r]=NEG; } }
template<int THRL> __device__ __forceinline__ void attn_unit(const bf16*Q0,const bf16*__restrict__ Kh,const bf16*__restrict__ Vh,long metarow,bf16*O0,int nvalid,char*shm){
  const int tid=threadIdx.x,lane=tid&63,r32=lane&31,hi=lane>>5; const int wid=__builtin_amdgcn_readfirstlane(tid>>6);
  const bf16*Qw=Q0+(long)(wid*QBLK)*PQ;
  const unsigned lds0=(unsigned)(uintptr_t)shm;
  float*wsf=(float*)(shm+LDS_WS)+wid*64;
  const bf16*ksrc=Kh+(long)lane*PQ+wid*8;
  const bf16*vsrc=Vh+(long)(16*(wid&3)+(lane>>2))*PQ+(wid>>2)*32+(lane&3)*8;
  const unsigned kdst=lds0+LDS_K+wid*1024, vdst=lds0+LDS_V+wid*1024;
  #define TOFF(t) (((t)<NT-2?(long)(t)*KVBLK:metarow)*PQ)
  #define DMA_K(t,slot) glds16(ksrc+TOFF(t),(unsigned)__builtin_amdgcn_readfirstlane(kdst+(slot)))
  #define DMA_V(t,slot) glds16(vsrc+TOFF(t),(unsigned)__builtin_amdgcn_readfirstlane(vdst+(slot)))
  const int vb0=(int)(lds0+LDS_V)+((lane>>4)&1)*32+(lane&3)*8+(4*hi+((lane&15)>>2))*64;
  const char*Kbase=shm+LDS_K; bf16x8 kf[8];
  const lds_cptr shm3=(lds_cptr)shm; const lds_cptr kp0=shm3+LDS_K+hi*1024+r32*16; const lds_cptr vp0=shm3+LDS_V+((lane>>4)&1)*32+(lane&3)*8+(4*hi+((lane&15)>>2))*64;
  DMA_K(0,0);DMA_V(0,0);DMA_K(1,SLOTB);
  bf16x8 qr[4];
  #pragma unroll
  for(int d0=0;d0<4;++d0)qr[d0]=*reinterpret_cast<const bf16x8*>(&Qw[(long)r32*PQ+d0*16+hi*8]);
  float mhat=0.f,l_reg=0.f;f32x16 o[2];o[0]=f32x16{};o[1]=f32x16{};f32x16 negm=f32x16{};asm volatile("":"+v"(negm));
  #define CMASK(P0,P1,t) do{ if((t)>=NT-2) tmask(P0,P1,(t)==NT-1); }while(0)
  bool resc=false;
  #define START(P0,P1) do{ const float rm=rowmax(P0,P1); resc=false; \
    { const float dl=rm; mhat=fadd_s(mhat,dl); \
      _Pragma("unroll") for(int r=0;r<16;++r){P0[r]=fsub_s(P0[r],dl);P1[r]=fsub_s(P1[r],dl);} \
      _Pragma("unroll") for(int r=0;r<16;++r)negm[r]=-mhat; asm volatile("":"+v"(negm)); } \
    _Pragma("unroll") for(int r=0;r<16;++r)P0[r]=__builtin_amdgcn_exp2f(P0[r]); }while(0)
  #define RESC() do{ if(resc){ asm volatile("s_waitcnt lgkmcnt(0)":::"memory"); \
      _Pragma("unroll") for(int d_=0;d_<2;++d_) _Pragma("unroll") for(int r=0;r<16;++r)o[d_][r]*=wsf[crow(r,hi)]; } }while(0)
  f32x16 pA0,pA1,pB0,pB1;
  int sl_prev=0,sl_cur=0,sl_next=SLOTB;
  #define ROT() do{sl_prev=sl_cur;sl_cur=sl_next;sl_next=(sl_next==(NSLOT-1)*SLOTB)?0:sl_next+SLOTB;}while(0)
  DMA_K(2,2*SLOTB);
  WAIT_BAR(3);
  qkt(pA0,pA1,Kbase,qr,negm,r32,hi);asm volatile("s_nop 15\n\ts_nop 7":"+v"(pA0),"+v"(pA1));CMASK(pA0,pA1,0);
  START(pA0,pA1);
  _Pragma("unroll") for(int r=0;r<16;++r)pA1[r]=__builtin_amdgcn_exp2f(pA1[r]);
  WAIT_BAR(0);
  DMA_K(3,0);DMA_V(1,SLOTB);
  ROT();
  kload8(kf,kp0+sl_cur);
  WAIT_BAR(2);
  s16x4 vlo[8],vhi[8]; u32x4 pw0,pw1,pw2,pw3;
  #define PKW(P,B) cvtpk_s(P[B],P[B+1])
  #define PAF(k) __builtin_bit_cast(bf16x8,pw##k)
  #define VFR(i) (bf16x8){vlo[i][0],vlo[i][1],vlo[i][2],vlo[i][3],vhi[i][0],vhi[i][1],vhi[i][2],vhi[i][3]}
  #define PIN(x) asm volatile("":"+v"(x))
  #define MX3(a,b,c) __builtin_fmaxf(__builtin_fmaxf((a),(b)),(c))
  #define GAPA(MF,A0,A1,A2,A3,W0,W1,PW) do{ MF; sacc+=A0; sacc+=A1; sacc+=A2; sacc+=A3; PIN(sacc); W0; W1; PIN(PW); SBAR(); }while(0)
  #define EX(v) __builtin_amdgcn_exp2f(v)
  #define GAPB(MF,X,B) do{ MF; X[B]=EX(X[B]); X[B+1]=EX(X[B+1]); X[B+2]=EX(X[B+2]); X[B+3]=EX(X[B+3]); PIN(X); SBAR(); }while(0)
  #define VRD(i) do{ vlo[i]=vtr(vp_+(((i)>>2)*4096+((i)&3)*1024)); vhi[i]=vtr(vp_+(((i)>>2)*4096+((i)&3)*1024+512)); }while(0)
  #define KRD(G,j) do{ if(G){ kload2(kf,kp0+sl_next,j); SBAR(); } }while(0)
  #define STEP(C0,C1,P0,P1,t,GK,GV,GL) do{ SBAR(); \
    const lds_cptr vp_=vp0+sl_prev; \
    VRD(0); SBAR(); float sacc=(P0[0]+P0[1]); \
    GAPA(C0=__builtin_amdgcn_mfma_f32_32x32x16_bf16(kf[0],qr[0],negm,0,0,0), P0[2],P0[3],P0[4],P0[5],     pw0[0]=PKW(P0,0), pw0[1]=PKW(P0,2), pw0); \
    VRD(4); SBAR(); GAPA(C1=__builtin_amdgcn_mfma_f32_32x32x16_bf16(kf[1],qr[0],negm,0,0,0), P0[6],P0[7],P0[8],P0[9],     pw0[2]=PKW(P0,4), pw0[3]=PKW(P0,6), pw0); \
    VRD(1); SBAR(); GAPA(C0=__builtin_amdgcn_mfma_f32_32x32x16_bf16(kf[2],qr[1],C0,0,0,0),   P0[10],P0[11],P0[12],P0[13], pw1[0]=PKW(P0,8), pw1[1]=PKW(P0,10), pw1); \
    VRD(5); SBAR(); GAPA(C1=__builtin_amdgcn_mfma_f32_32x32x16_bf16(kf[3],qr[1],C1,0,0,0),   P0[14],P0[15],P1[0],P1[1],   pw1[2]=PKW(P0,12),pw1[3]=PKW(P0,14), pw1); \
    VRD(2); SBAR(); GAPA(C0=__builtin_amdgcn_mfma_f32_32x32x16_bf16(kf[4],qr[2],C0,0,0,0),   P1[2],P1[3],P1[4],P1[5],     pw2[0]=PKW(P1,0), pw2[1]=PKW(P1,2), pw2); \
    VRD(6); SBAR(); GAPA(C1=__builtin_amdgcn_mfma_f32_32x32x16_bf16(kf[5],qr[2],C1,0,0,0),   P1[6],P1[7],P1[8],P1[9],     pw2[2]=PKW(P1,4), pw2[3]=PKW(P1,6), pw2); \
    VRD(3); SBAR(); GAPA(C0=__builtin_amdgcn_mfma_f32_32x32x16_bf16(kf[6],qr[3],C0,0,0,0),   P1[10],P1[11],P1[12],P1[13], pw3[0]=PKW(P1,8), pw3[1]=PKW(P1,10), pw3); \
    VRD(7); SBAR(); GAPA(C1=__builtin_amdgcn_mfma_f32_32x32x16_bf16(kf[7],qr[3],C1,0,0,0),   P1[14],P1[15],0.f,0.f,       pw3[2]=PKW(P1,12),pw3[3]=PKW(P1,14), pw3); \
    l_reg+=sacc; \
    if(GK){DMA_K((t)+3,sl_cur);} if(GV){DMA_V((t)+1,sl_next);} \
    CMASK(C0,C1,t); \
    { float a=MX3(C0[0],C0[1],C1[0]),b=MX3(C0[2],C0[3],C1[1]); a=MX3(a,C1[2],C1[3]); \
      _Pragma("unroll") for(int r=4;r<16;r+=4){a=MX3(a,C0[r],C0[r+1]);b=MX3(b,C0[r+2],C0[r+3]);a=MX3(a,C1[r],C1[r+1]);b=MX3(b,C1[r+2],C1[r+3]);} \
      float rm=__builtin_fmaxf(a,b); { auto rr=__builtin_amdgcn_permlane32_swap(__float_as_uint(rm),__float_as_uint(rm),false,false); rm=__builtin_fmaxf(__uint_as_float(rr[0]),__uint_as_float(rr[1])); } \
      resc=false; \
      if(__builtin_expect(__any(rm>(float)THRL),0)){ const float dl=__builtin_fmaxf(rm,0.f); mhat+=dl; \
        _Pragma("unroll") for(int r=0;r<16;++r){C0[r]-=dl;C1[r]-=dl;} \
        _Pragma("unroll") for(int r=0;r<16;++r)negm[r]=-mhat; asm volatile("":"+v"(negm)); \
        const float f=__builtin_amdgcn_exp2f(-dl); l_reg*=f; if(hi==0)wsf[r32]=f; resc=true; } } \
    SBAR(); \
    GAPB(o[0]=__builtin_amdgcn_mfma_f32_32x32x16_bf16(PAF(0),VFR(0),o[0],0,0,0), C0,0); \
    GAPB(o[1]=__builtin_amdgcn_mfma_f32_32x32x16_bf16(PAF(0),VFR(4),o[1],0,0,0), C0,4); \
    KRD(GL,0); GAPB(o[0]=__builtin_amdgcn_mfma_f32_32x32x16_bf16(PAF(1),VFR(1),o[0],0,0,0), C0,8); \
    KRD(GL,1); GAPB(o[1]=__builtin_amdgcn_mfma_f32_32x32x16_bf16(PAF(1),VFR(5),o[1],0,0,0), C0,12); \
    KRD(GL,2); GAPB(o[0]=__builtin_amdgcn_mfma_f32_32x32x16_bf16(PAF(2),VFR(2),o[0],0,0,0), C1,0); \
    KRD(GL,3); GAPB(o[1]=__builtin_amdgcn_mfma_f32_32x32x16_bf16(PAF(2),VFR(6),o[1],0,0,0), C1,4); \
    GAPB(o[0]=__builtin_amdgcn_mfma_f32_32x32x16_bf16(PAF(3),VFR(3),o[0],0,0,0), C1,8); \
    GAPB(o[1]=__builtin_amdgcn_mfma_f32_32x32x16_bf16(PAF(3),VFR(7),o[1],0,0,0), C1,12); \
    }while(0)
  int t=1;
  #undef CMASK
  #define CMASK(P0,P1,t) do{}while(0)
  for(;t+5<NT;t+=2){
    STEP(pB0,pB1,pA0,pA1,t,true,true,true);     WAIT_BAR(2); RESC(); ROT();
    STEP(pA0,pA1,pB0,pB1,t+1,true,true,true);   WAIT_BAR(2); RESC(); ROT();
  }
  #undef CMASK
  #define CMASK(P0,P1,t) do{ if((t)>=NT-2) tmask(P0,P1,(t)==NT-1); }while(0)
  #define ENDW(tt) do{ if((tt)+3<NT){WAIT_BAR(2);} else if((tt)+2<NT){WAIT_BAR(1);} else {WAIT_BAR(0);} }while(0)
  for(;t+1<NT;t+=2){
    STEP(pB0,pB1,pA0,pA1,t,(t+3<NT),(t+1<NT),(t+1<NT));       ENDW(t);   RESC(); ROT();
    STEP(pA0,pA1,pB0,pB1,t+1,(t+4<NT),(t+2<NT),(t+2<NT));     ENDW(t+1); RESC(); ROT();
  }
  STEP(pB0,pB1,pA0,pA1,NT-1,false,false,false); RESC();
  { float sacc=pB0[0]+pB0[1]; _Pragma("unroll") for(int r=2;r<16;++r)sacc+=pB0[r]; _Pragma("unroll") for(int r=0;r<16;++r)sacc+=pB1[r]; l_reg+=sacc;
    pw0=(u32x4){PKW(pB0,0),PKW(pB0,2),PKW(pB0,4),PKW(pB0,6)};pw1=(u32x4){PKW(pB0,8),PKW(pB0,10),PKW(pB0,12),PKW(pB0,14)};pw2=(u32x4){PKW(pB1,0),PKW(pB1,2),PKW(pB1,4),PKW(pB1,6)};pw3=(u32x4){PKW(pB1,8),PKW(pB1,10),PKW(pB1,12),PKW(pB1,14)};
    SBAR(); pv(o,vb0+sl_cur,PAF(0),PAF(1),PAF(2),PAF(3)); }
  #undef PKW
  #undef PAF
  #undef VFR
  #undef PIN
  #undef MX3
  #undef GAPA
  #undef GAPB
  #undef EX
  #undef VRD
  #undef KRD
  #undef STEP
  #undef ENDW
  {auto rr=__builtin_amdgcn_permlane32_swap(__float_as_uint(l_reg),__float_as_uint(l_reg),false,false);l_reg=__uint_as_float(rr[0])+__uint_as_float(rr[1]);}
  if(hi==0)wsf[32+r32]=l_reg;asm volatile("s_waitcnt lgkmcnt(0)":::"memory");
  float rli[16];
  #pragma unroll
  for(int r=0;r<16;++r)rli[r]=__builtin_amdgcn_rcpf(wsf[32+crow(r,hi)]);
  bf16*Ow=O0+(long)(wid*QBLK)*PO;
  { bf16*stg=(bf16*)(shm+LDS_OST)+wid*2048;
    #pragma unroll
    for(int r=0;r<16;++r){const int orow=crow(r,hi);
      #pragma unroll
      for(int d0=0;d0<2;++d0)stg[orow*64+d0*32+r32]=__float2bfloat16(o[d0][r]*rli[r]);}
    asm volatile("s_waitcnt lgkmcnt(0)":::"memory");
    #pragma unroll
    for(int i=0;i<4;++i){const int row=i*8+(lane>>3),ch=lane&7; const u32x4 v=*(const u32x4*)(stg+row*64+ch*8); if(wid*QBLK+row<nvalid)ATTN_STORE16(Ow+(long)row*PO+ch*8,v);} }
  asm volatile("s_waitcnt lgkmcnt(0)\n\ts_barrier":::"memory");
  #undef TOFF
  #undef DMA_K
  #undef DMA_V
  #undef CMASK
  #undef START
  #undef RESC
  #undef ROT
}
constexpr int ATTN_LDS_BYTES=LDS_BYTES;
#undef SBAR
#undef WAIT_BAR
}
namespace cg = cooperative_groups;
#define LAS __attribute__((address_space(3)))
typedef unsigned short bf16_t;
typedef float f32x4 __attribute__((ext_vector_type(4)));
typedef unsigned v4u __attribute__((ext_vector_type(4)));
constexpr int NWAVES = 8, NTHREADS = 512;
constexpr int D = 1024, FF = 2816, MREAL = 16384, MVALID = 16416, MPAD = 16640, QKVW = 1536, QKV_ROWS = 16704;
constexpr int S5R = 1026;
constexpr float LN_EPS = 1e-5f, QK_EPS = 1e-6f;
constexpr float DN_ALPHA = 1.681792830507429f;
constexpr size_t MiB = 1u << 20;
constexpr size_t WS_WMIX = 1 * MiB, WS_WGU = 7 * MiB, WS_WDN = 18 * MiB, WS_TMAT = 24 * MiB, WS_BPOW = 40 * MiB, WS_A16 = 48 * MiB, WS_HMETA = 49 * MiB, WS_HB = 50 * MiB, WS_X = 83 * MiB;
constexpr size_t WS_AG = WS_X, WS_SLOC = WS_X + 65 * MiB, WS_G = WS_SLOC, WS_Z = WS_G + 33 * MiB;
constexpr size_t WS_QKV = WS_X, WS_O = WS_X + 49 * MiB;
constexpr size_t WS_FF = WS_X;
constexpr size_t WS_END = 256 * MiB;
static_assert(WS_Z + 33 * MiB <= WS_END && WS_O + 33 * MiB <= WS_END && WS_FF + (size_t)MPAD * FF * 2 <= WS_END, "ws map");
static_assert((size_t)(64 * S5R + 256) * 1024 <= 65 * MiB && (size_t)64 * S5R * 1024 <= 65 * MiB && (size_t)QKV_ROWS * QKVW * 2 <= 49 * MiB && (size_t)MPAD * D * 2 <= 33 * MiB, "ws map 2");
constexpr int LDS_BYTES = 147456, RING_BYTES = 131072;

struct Args {
    const float *x, *meta, *lam_re, *lam_im, *log_dt, *b_re, *b_im, *c_re, *c_im, *s5d, *w_glu, *w_sout, *w_qkv, *q_gain, *k_gain, *w_aout, *w_gate, *w_up, *w_down, *ln_g, *ln_b;
    float* out; unsigned char* ws; int ph_lo, ph_hi;
};

__device__ __forceinline__ unsigned f2bf(float f) { unsigned u = __builtin_bit_cast(unsigned, f); return (u + 0x7fffu + ((u >> 16) & 1u)) >> 16; }
__device__ __forceinline__ unsigned pk2(float lo, float hi) { return f2bf(lo) | (f2bf(hi) << 16); }
__device__ __forceinline__ unsigned long long pk4(f32x4 v) { return (unsigned long long)pk2(v.x, v.y) | ((unsigned long long)pk2(v.z, v.w) << 32); }
__device__ __forceinline__ float wave_sum(float v) {
#pragma unroll
    for (int o = 1; o < 64; o <<= 1) v += __shfl_xor(v, o);
    return v;
}
#define LDS_WAIT() asm volatile("s_waitcnt lgkmcnt(0)" ::: "memory")

__device__ __forceinline__ void transpose_item(const float* W, int K, int N, bf16_t* WT, int mode, LAS float* scr, int item, int lane) {
    const int nblk = N / 32, kb = item / nblk, nb = item % nblk, k0 = 64 * kb, n0 = 32 * nb;
    const int orow0 = (mode == 0) ? n0 : ((n0 >> 7) * 256 + (mode - 1) * 128 + (n0 & 127));
#pragma unroll 8
    for (int i = 0; i < 32; ++i) { const int kk = 2 * i + (lane >> 5); scr[kk * 33 + (lane & 31)] = W[(size_t)(k0 + kk) * N + n0 + (lane & 31)]; }
    LDS_WAIT(); asm volatile("" ::: "memory");
    const int c = lane & 7;
#pragma unroll
    for (int j = 0; j < 4; ++j) { const int n = (lane >> 3) + 8 * j; const LAS float* s = scr + (8 * c) * 33 + n;
        v4u o; o.x = pk2(s[0 * 33], s[1 * 33]); o.y = pk2(s[2 * 33], s[3 * 33]); o.z = pk2(s[4 * 33], s[5 * 33]); o.w = pk2(s[6 * 33], s[7 * 33]);
        *(v4u*)(WT + (size_t)(orow0 + n) * K + k0 + 8 * c) = o; }
    LDS_WAIT(); asm volatile("" ::: "memory");
}
__device__ __forceinline__ void convert_weights(const Args& a, int which, int j, LAS unsigned char* lds, int gw, int ngw, int wave, int lane) {
    LAS float* scr = (LAS float*)(lds + wave * 16384);
    unsigned char* ws = a.ws;
    if (which == 0) {
        constexpr int I = (D / 64) * (D / 32);
        for (int it = gw; it < 2 * I; it += ngw) {
            if (it < I) transpose_item(a.w_glu + (size_t)j * D * D, D, D, (bf16_t*)(ws + WS_WMIX), 0, scr, it, lane);
            else transpose_item(a.w_sout + (size_t)j * D * D, D, D, (bf16_t*)(ws + WS_WMIX + 2 * MiB), 0, scr, it - I, lane);
        }
    } else if (which == 1) {
        constexpr int I1 = (D / 64) * (QKVW / 32), I2 = (D / 64) * (D / 32);
        for (int it = gw; it < I1 + I2; it += ngw) {
            if (it < I1) transpose_item(a.w_qkv + (size_t)j * D * QKVW, D, QKVW, (bf16_t*)(ws + WS_WMIX), 0, scr, it, lane);
            else transpose_item(a.w_aout + (size_t)j * D * D, D, D, (bf16_t*)(ws + WS_WMIX + 3 * MiB), 0, scr, it - I1, lane);
        }
    } else {
        constexpr int I1 = (D / 64) * (FF / 32), I3 = (FF / 64) * (D / 32);
        for (int it = gw; it < 2 * I1 + I3; it += ngw) {
            if (it < I1) transpose_item(a.w_gate + (size_t)j * D * FF, D, FF, (bf16_t*)(ws + WS_WGU), 1, scr, it, lane);
            else if (it < 2 * I1) transpose_item(a.w_up + (size_t)j * D * FF, D, FF, (bf16_t*)(ws + WS_WGU), 2, scr, it - I1, lane);
            else transpose_item(a.w_down + (size_t)j * FF * D, FF, D, (bf16_t*)(ws + WS_WDN), 0, scr, it - 2 * I1, lane);
        }
    }
}
__device__ __forceinline__ void s5_tables(const Args& a, int j, int g, LAS float* L, int tid) {
    LAS float* apw = L;
    LAS float* Bb = L + 4352;
    LAS float* Cc = Bb + 4096;
    LAS float* Kt = Cc + 4096;
    bf16_t* Tmat = (bf16_t*)(a.ws + WS_TMAT) + (size_t)g * 256 * 512;
    bf16_t* Bpow = (bf16_t*)(a.ws + WS_BPOW) + (size_t)g * 256 * 256;
    float* A16 = (float*)(a.ws + WS_A16);
    if (tid < 128) {
        const int dir = tid >> 6, p = tid & 63; const size_t gi = ((size_t)(j * 2 + dir) * 64 + g);
        const float lr = a.lam_re[gi * 64 + p], li = a.lam_im[gi * 64 + p], dt = expf(a.log_dt[gi]);
        const float mag = expf(lr * dt), abr = mag * cosf(li * dt), abi = mag * sinf(li * dt);
        const float nr = abr - 1.0f, ni = abi, den = lr * lr + li * li, cr = (nr * lr + ni * li) / den, ci = (ni * lr - nr * li) / den;
        float pr = 1.f, pi = 0.f;
        for (int k = 0; k <= 16; ++k) { apw[((dir * 17 + k) * 64 + p) * 2] = pr; apw[((dir * 17 + k) * 64 + p) * 2 + 1] = pi; const float t = pr * abr - pi * abi; pi = pr * abi + pi * abr; pr = t; }
        A16[((g * 2 + dir) * 64 + p) * 2] = apw[((dir * 17 + 16) * 64 + p) * 2]; A16[((g * 2 + dir) * 64 + p) * 2 + 1] = apw[((dir * 17 + 16) * 64 + p) * 2 + 1];
        for (int c = 0; c < 16; ++c) { const float br = a.b_re[(gi * 64 + p) * 16 + c], bi = a.b_im[(gi * 64 + p) * 16 + c];
            Bb[((dir * 64 + p) * 16 + c) * 2] = cr * br - ci * bi; Bb[((dir * 64 + p) * 16 + c) * 2 + 1] = cr * bi + ci * br; }
    }
    for (int q = 0; q < 4; ++q) { const int idx = tid + 512 * q, dir = idx >> 10, co = (idx >> 6) & 15, p = idx & 63; const size_t ci_ = (((size_t)(j * 2 + dir) * 64 + g) * 16 + co) * 64 + p;
        Cc[idx * 2] = a.c_re[ci_]; Cc[idx * 2 + 1] = a.c_im[ci_]; }
    __syncthreads();
    for (int q = 0; q < 16; ++q) { const int o = tid + 512 * q, dir = o >> 12, k = (o >> 8) & 15, co = (o >> 4) & 15, ci = o & 15; float s = 0.f;
        for (int p = 0; p < 64; ++p) { const float ar = apw[((dir * 17 + k) * 64 + p) * 2], ai = apw[((dir * 17 + k) * 64 + p) * 2 + 1], br = Bb[((dir * 64 + p) * 16 + ci) * 2], bi = Bb[((dir * 64 + p) * 16 + ci) * 2 + 1];
            const float wr = ar * br - ai * bi, wi = ar * bi + ai * br; s += Cc[((dir * 16 + co) * 64 + p) * 2] * wr - Cc[((dir * 16 + co) * 64 + p) * 2 + 1] * wi; }
        Kt[o] = s; }
    __syncthreads();
    { const int n = tid >> 1, half = tid & 1, t = n >> 4, co = n & 15; bf16_t* rowp = Tmat + (size_t)n * 512 + half * 256;
        if (half == 0) {
            for (int s = 0; s < 16; ++s) { float v[16];
#pragma unroll
                for (int ci = 0; ci < 16; ++ci) { float x = 0.f; if (s <= t) x += Kt[((0 * 16 + (t - s)) * 16 + co) * 16 + ci]; if (s >= t) x += Kt[((1 * 16 + (s - t)) * 16 + co) * 16 + ci]; v[ci] = x; }
                v4u o0, o1; o0.x = pk2(v[0], v[1]); o0.y = pk2(v[2], v[3]); o0.z = pk2(v[4], v[5]); o0.w = pk2(v[6], v[7]); o1.x = pk2(v[8], v[9]); o1.y = pk2(v[10], v[11]); o1.z = pk2(v[12], v[13]); o1.w = pk2(v[14], v[15]);
                *(v4u*)(rowp + s * 16) = o0; *(v4u*)(rowp + s * 16 + 8) = o1; }
        } else {
            for (int q = 0; q < 32; ++q) { float v[8];
                const int dir = q >> 4, ri = (q >> 3) & 1, ex = dir == 0 ? t + 1 : 16 - t;
#pragma unroll
                for (int e = 0; e < 8; ++e) { const int p = 8 * (q & 7) + e; const float cr = Cc[((dir * 16 + co) * 64 + p) * 2], ci = Cc[((dir * 16 + co) * 64 + p) * 2 + 1], ar = apw[((dir * 17 + ex) * 64 + p) * 2], ai = apw[((dir * 17 + ex) * 64 + p) * 2 + 1];
                    v[e] = ri == 0 ? (cr * ar - ci * ai) : -(cr * ai + ci * ar); }
                v4u o0; o0.x = pk2(v[0], v[1]); o0.y = pk2(v[2], v[3]); o0.z = pk2(v[4], v[5]); o0.w = pk2(v[6], v[7]); *(v4u*)(rowp + q * 8) = o0; }
        }
    }
    { const int n = tid >> 1, half = tid & 1, dir = n >> 7, ri = (n >> 6) & 1, p = n & 63; bf16_t* rowp = Bpow + (size_t)n * 256 + half * 128;
        for (int s8 = 0; s8 < 8; ++s8) { const int s = 8 * half + s8, ex = dir == 0 ? 15 - s : s; const float ar = apw[((dir * 17 + ex) * 64 + p) * 2], ai = apw[((dir * 17 + ex) * 64 + p) * 2 + 1]; float v[16];
#pragma unroll
            for (int ci = 0; ci < 16; ++ci) { const float br = Bb[((dir * 64 + p) * 16 + ci) * 2], bi = Bb[((dir * 64 + p) * 16 + ci) * 2 + 1]; v[ci] = ri == 0 ? (ar * br - ai * bi) : (ar * bi + ai * br); }
            v4u o0, o1; o0.x = pk2(v[0], v[1]); o0.y = pk2(v[2], v[3]); o0.z = pk2(v[4], v[5]); o0.w = pk2(v[6], v[7]); o1.x = pk2(v[8], v[9]); o1.y = pk2(v[10], v[11]); o1.z = pk2(v[12], v[13]); o1.w = pk2(v[14], v[15]);
            *(v4u*)(rowp + s8 * 16) = o0; *(v4u*)(rowp + s8 * 16 + 8) = o1; }
    }
    __syncthreads();
}
__device__ __forceinline__ float* hrow(const Args& a, int m) { return m < MREAL ? a.out + (size_t)m * D : (float*)(a.ws + WS_HMETA) + (size_t)(m - MREAL) * D; }
__device__ __forceinline__ void write_row(const Args& a, int m, const f32x4 (&v)[4], bf16_t* ag, int lane) {
    f32x4* ho = (f32x4*)hrow(a, m) + lane;
    unsigned long long* o8 = (unsigned long long*)((bf16_t*)(a.ws + WS_HB) + (size_t)m * D) + lane;
#pragma unroll
    for (int j = 0; j < 4; ++j) { ho[64 * j] = v[j]; o8[64 * j] = pk4(v[j]); }
    if (ag && m < MVALID) {
#pragma unroll
        for (int j = 0; j < 4; ++j) { const int g = (lane >> 2) + 16 * j; *(unsigned long long*)(ag + ((size_t)g * S5R + (m >> 4)) * 512 + (m & 15) * 16 + 4 * (lane & 3)) = pk4(v[j]); }
    }
}
__device__ __forceinline__ void init_rows(const Args& a, int gw, int ngw, int lane) {
    bf16_t* ag = (bf16_t*)(a.ws + WS_AG);
    for (int m = gw; m < MPAD; m += ngw) { f32x4 v[4];
        const float* src = m < MREAL ? a.x + (size_t)m * D : a.meta + (size_t)((m - MREAL) & 15) * D;
#pragma unroll
        for (int j = 0; j < 4; ++j) v[j] = m < MVALID ? ((const f32x4*)src)[lane + 64 * j] : (f32x4){0.f, 0.f, 0.f, 0.f};
        write_row(a, m, v, ag, lane); }
}
__device__ __forceinline__ void ln_phase(const Args& a, int lnidx, bool want_ag, int gw, int ngw, int lane) {
    bf16_t* ag = want_ag ? (bf16_t*)(a.ws + WS_AG) : nullptr;
    f32x4 gn[4], bs[4];
#pragma unroll
    for (int j = 0; j < 4; ++j) { gn[j] = ((const f32x4*)(a.ln_g + (size_t)lnidx * D))[lane + 64 * j]; bs[j] = ((const f32x4*)(a.ln_b + (size_t)lnidx * D))[lane + 64 * j]; }
    for (int m = gw; m < MPAD; m += ngw) { f32x4 v[4];
        if (m < MVALID) { const f32x4* xr = (const f32x4*)hrow(a, m) + lane; float s = 0.f;
#pragma unroll
            for (int j = 0; j < 4; ++j) { v[j] = xr[64 * j]; s += (v[j].x + v[j].y) + (v[j].z + v[j].w); }
            const float mean = wave_sum(s) * (1.f / D); float s2 = 0.f;
#pragma unroll
            for (int j = 0; j < 4; ++j) { v[j] = v[j] - mean; s2 += (v[j].x * v[j].x + v[j].y * v[j].y) + (v[j].z * v[j].z + v[j].w * v[j].w); }
            const float rstd = 1.f / sqrtf(wave_sum(s2) * (1.f / D) + LN_EPS);
#pragma unroll
            for (int j = 0; j < 4; ++j) v[j] = v[j] * rstd * gn[j] + bs[j];
        } else {
#pragma unroll
            for (int j = 0; j < 4; ++j) v[j] = (f32x4){0.f, 0.f, 0.f, 0.f};
        }
        write_row(a, m, v, ag, lane); }
}
__device__ __forceinline__ void s5_scan(const Args& a, int task, int lane) {
    const int g = task >> 2, b = (task >> 1) & 1, dir = task & 1;
    const float* A16 = (const float*)(a.ws + WS_A16); const float ar = A16[((g * 2 + dir) * 64 + lane) * 2], ai = A16[((g * 2 + dir) * 64 + lane) * 2 + 1];
    const float* Sl = (const float*)(a.ws + WS_SLOC) + (size_t)g * S5R * 256 + dir * 128 + lane;
    bf16_t* Ag = (bf16_t*)(a.ws + WS_AG) + (size_t)g * S5R * 512 + 256 + dir * 128 + lane;
    float sr = 0.f, si = 0.f;
#define S5ROW(c) ((c) == 0 ? 1024 + b : 512 * b + (c) - 1)
    for (int base = 0; base < 512; base += 32) { float lr[32], li[32];
#pragma unroll
        for (int q = 0; q < 32; ++q) { const int c = dir == 0 ? base + q : 512 - (base + q); const int r = S5ROW(c); lr[q] = Sl[(size_t)r * 256]; li[q] = Sl[(size_t)r * 256 + 64]; }
#pragma unroll
        for (int q = 0; q < 32; ++q) { const int c = dir == 0 ? base + q : 512 - (base + q); const int r = S5ROW(c);
            Ag[(size_t)r * 512] = (bf16_t)f2bf(sr); Ag[(size_t)r * 512 + 64] = (bf16_t)f2bf(si);
            const float t = ar * sr - ai * si + lr[q]; si = ar * si + ai * sr + li[q]; sr = t; }
    }
    { const int c = dir == 0 ? 512 : 0; const int r = S5ROW(c); Ag[(size_t)r * 512] = (bf16_t)f2bf(sr); Ag[(size_t)r * 512 + 64] = (bf16_t)f2bf(si); }
#undef S5ROW
}
__device__ __forceinline__ void normrope_phase(const Args& a, int j, int gw, int ngw, int lane) {
    bf16_t* QKV = (bf16_t*)(a.ws + WS_QKV);
    const float qg = a.q_gain[j * 64 + lane] * attn_body::C2, kg = a.k_gain[j * 64 + lane];
    const int i = lane & 15, axis = lane >> 5; const float invf = exp2f(-(float)i * 0.8304820237218406f);
    const bool second = (lane >> 4) & 1;
    for (int m = gw; m < MVALID; m += ngw) {
        const int t = m & 8191; const float pos = m < MREAL ? (float)(axis ? (t & 63) : (t >> 6)) : 0.f;
        const float ang = pos * invf, cs = cosf(ang), sn = sinf(ang);
        bf16_t* row = QKV + (size_t)m * QKVW + lane; float x[20];
#pragma unroll
        for (int h = 0; h < 20; ++h) x[h] = __uint_as_float((unsigned)row[h * 64] << 16);
#pragma unroll
        for (int h = 0; h < 20; ++h) { const float ss = wave_sum(x[h] * x[h]); const float y = x[h] * (1.f / sqrtf(ss * (1.f / 64.f) + QK_EPS)) * (h < 16 ? qg : kg);
            const float o = __shfl_xor(y, 16); const float r = second ? (y * cs + o * sn) : (y * cs - o * sn); row[h * 64] = (bf16_t)f2bf(r); }
    }
}
constexpr int NPH = 35;
enum { K_P0, K_S5A, K_S5B, K_S5C, K_GLU, K_RESMIX, K_LN1, K_GU, K_RESDN, K_LN2, K_QKV, K_ROPE, K_ATTN };
template <int KIND, int LAYER>
__device__ __forceinline__ void run_phase(const Args& a, unsigned char* lds, int G, int bx, int vcu) {
    int tid_ = threadIdx.x; asm volatile("" : "+v"(tid_));
    const int tid = tid_, lane = tid & 63, wave = __builtin_amdgcn_readfirstlane(tid >> 6);
    const int gw = vcu * NWAVES + wave, ngw = G * NWAVES;
    LAS unsigned char* L = (LAS unsigned char*)lds;
    unsigned char* ws = a.ws;
    float* hmeta = (float*)(ws + WS_HMETA);
    constexpr int layer = LAYER, j = LAYER >> 1; constexpr bool is_attn = LAYER & 1;
    if constexpr (KIND == K_P0) {
        convert_weights(a, 0, 0, L, gw, ngw, wave, lane);
        convert_weights(a, 2, 0, L, gw, ngw, wave, lane);
        __syncthreads();
        for (int g = bx; g < 64; g += G) s5_tables(a, 0, g, (LAS float*)L, tid);
        init_rows(a, gw, ngw, lane);
    } else if constexpr (KIND == K_S5A) {
        pg8::Gemm g{(const bf16_t*)(ws + WS_AG), (const bf16_t*)(ws + WS_BPOW), 0, 256, 256, 512};
        pg8::S5Order S{G, bx, 1024, 512}; pg8::EpiS5a E{(float*)(ws + WS_SLOC)};
        pg8::gemm_phase<pg8::EpiS5a, pg8::S5Order, true, true>(L, g, S, E);
        if constexpr (layer > 0) convert_weights(a, 2, layer, L, gw, ngw, wave, lane);
    } else if constexpr (KIND == K_S5B) {
        if (wave == 0) for (int task = bx; task < 256; task += G) s5_scan(a, task, lane);
    } else if constexpr (KIND == K_S5C) {
        pg8::Gemm g{(const bf16_t*)(ws + WS_AG), (const bf16_t*)(ws + WS_TMAT), 0, 256, 512, 512};
        pg8::S5Order S{G, bx, 1024, 1024}; pg8::EpiS5c E{a.out, hmeta, a.s5d + (size_t)j * D, (bf16_t*)(ws + WS_G)};
        pg8::gemm_phase<pg8::EpiS5c, pg8::S5Order, true, true>(L, g, S, E);
    } else if constexpr (KIND == K_GLU) {
        pg8::Gemm g{(const bf16_t*)(ws + WS_G), (const bf16_t*)(ws + WS_WMIX), MPAD, D, D, D}; pg8::StaticOrder S; S.init(MPAD, D, D, D, G, bx);
        pg8::EpiGlu E{(const bf16_t*)(ws + WS_G), (bf16_t*)(ws + WS_Z)};
        pg8::gemm_phase<pg8::EpiGlu, pg8::StaticOrder, true, true>(L, g, S, E);
    } else if constexpr (KIND == K_RESMIX || KIND == K_RESDN) {
        constexpr bool dn = KIND == K_RESDN; constexpr int K = dn ? FF : D;
        const bf16_t* A = dn ? (const bf16_t*)(ws + WS_FF) : is_attn ? (const bf16_t*)(ws + WS_O) : (const bf16_t*)(ws + WS_Z);
        const bf16_t* Bt = dn ? (const bf16_t*)(ws + WS_WDN) : is_attn ? (const bf16_t*)(ws + WS_WMIX + 3 * MiB) : (const bf16_t*)(ws + WS_WMIX + 2 * MiB);
        pg8::Gemm g{A, Bt, MPAD, D, K, K}; pg8::StaticOrder S; S.init(MPAD, D, K, K, G, bx);
        pg8::EpiRes E{a.out, hmeta, DN_ALPHA};
        pg8::gemm_phase<pg8::EpiRes, pg8::StaticOrder, true, true>(L, g, S, E);
    } else if constexpr (KIND == K_LN1 || KIND == K_LN2) {
        constexpr bool second = KIND == K_LN2;
        ln_phase(a, layer * 2 + (second ? 1 : 0), second && layer < 3 && !((layer + 1) & 1), gw, ngw, lane);
    } else if constexpr (KIND == K_GU) {
        pg8::Gemm g{(const bf16_t*)(ws + WS_HB), (const bf16_t*)(ws + WS_WGU), MPAD, 2 * FF, D, D}; pg8::StaticOrder S; S.init(MPAD, 2 * FF, D, D, G, bx);
        pg8::EpiSwiGlu E{(bf16_t*)(ws + WS_FF), FF};
        pg8::gemm_phase<pg8::EpiSwiGlu, pg8::StaticOrder, true, true>(L, g, S, E);
        if constexpr (layer < 3) {
            convert_weights(a, (layer + 1) & 1, (layer + 1) >> 1, L, gw, ngw, wave, lane);
            if constexpr (!((layer + 1) & 1)) { __syncthreads(); for (int g2 = bx; g2 < 64; g2 += G) s5_tables(a, (layer + 1) >> 1, g2, (LAS float*)L, tid); }
        }
    } else if constexpr (KIND == K_QKV) {
        pg8::Gemm g{(const bf16_t*)(ws + WS_HB), (const bf16_t*)(ws + WS_WMIX), MPAD, QKVW, D, D}; pg8::StaticOrder S; S.init(MPAD, QKVW, D, D, G, bx);
        pg8::EpiBf16<0> E{(bf16_t*)(ws + WS_QKV), QKVW, nullptr, 0, 0, 1.f};
        pg8::gemm_phase<pg8::EpiBf16<0>, pg8::StaticOrder, true, true>(L, g, S, E);
        convert_weights(a, 2, layer, L, gw, ngw, wave, lane);
    } else if constexpr (KIND == K_ROPE) {
        normrope_phase(a, j, gw, ngw, lane);
    } else if constexpr (KIND == K_ATTN) {
        const attn_body::bf16* QKV = (const attn_body::bf16*)(ws + WS_QKV); attn_body::bf16* O = (attn_body::bf16*)(ws + WS_O);
        if (G == 256) {
#pragma unroll 1
            for (int i = 0; i < 5; ++i) {
                int b, h, nvalid; long rows0;
                if (i < 4) { const int bh = vcu >> 3; b = bh >> 4; h = bh & 15; rows0 = (long)b * 8192 + ((vcu & 7) * 4 + i) * 256; nvalid = 256; }
                else { if (vcu >= 32) break; b = vcu >> 4; h = vcu & 15; rows0 = MREAL + 16 * b; nvalid = 16; }
                const attn_body::bf16* Kh = QKV + (long)b * 8192 * attn_body::PQ + 1024 + (h >> 2) * 64;
                attn_body::attn_unit<8>(QKV + rows0 * attn_body::PQ + h * 64, Kh, Kh + 256, (long)(MREAL + 16 * b - 8192 * b), O + rows0 * attn_body::PO + h * 64, nvalid, (char*)lds);
            }
        }
    }
}
__global__ void __launch_bounds__(NTHREADS, 2) mk_fwd(Args a) {
    extern __shared__ __attribute__((aligned(16))) unsigned char lds[];
    cg::grid_group grid = cg::this_grid();
    const int G = gridDim.x, bx = blockIdx.x, vcu = (G % 8 == 0) ? (bx % 8) * (G / 8) + bx / 8 : bx;
    const int lo = a.ph_lo, hi = a.ph_hi;
#define PH(k, KIND, LAYER) if (lo <= (k) && (k) < hi) { run_phase<KIND, LAYER>(a, lds, G, bx, vcu); if ((k) + 1 < hi) grid.sync(); }
#define S5LAYER(k0, LY) PH(k0, K_S5A, LY) PH(k0 + 1, K_S5B, LY) PH(k0 + 2, K_S5C, LY) PH(k0 + 3, K_GLU, LY) PH(k0 + 4, K_RESMIX, LY) PH(k0 + 5, K_LN1, LY) PH(k0 + 6, K_GU, LY) PH(k0 + 7, K_RESDN, LY) PH(k0 + 8, K_LN2, LY)
#define ATLAYER(k0, LY) PH(k0, K_QKV, LY) PH(k0 + 1, K_ROPE, LY) PH(k0 + 2, K_ATTN, LY) PH(k0 + 3, K_RESMIX, LY) PH(k0 + 4, K_LN1, LY) PH(k0 + 5, K_GU, LY) PH(k0 + 6, K_RESDN, LY) PH(k0 + 7, K_LN2, LY)
    PH(0, K_P0, 0)
    S5LAYER(1, 0)
    ATLAYER(10, 1)
    S5LAYER(18, 2)
    ATLAYER(27, 3)
#undef PH
}

extern "C" void kernel_launch(void* const* d_in, const int* in_sizes, int n_in, void* d_out, int out_size, void* d_ws, size_t ws_size, hipStream_t stream) {
    static int grid = 0;
    if (grid == 0) {
        int dev = 0, cus = 0, per_cu = 0;
        if (n_in != 21 || out_size != MREAL * D || ws_size < WS_END) { fprintf(stderr, "kernel_launch: unexpected shapes (n_in %d out %d ws %zu)\n", n_in, out_size, ws_size); grid = -1; return; }
        hipGetDevice(&dev); hipDeviceGetAttribute(&cus, hipDeviceAttributeMultiprocessorCount, dev);
        hipFuncSetAttribute((const void*)mk_fwd, hipFuncAttributeMaxDynamicSharedMemorySize, LDS_BYTES);
        hipOccupancyMaxActiveBlocksPerMultiprocessor(&per_cu, (const void*)mk_fwd, NTHREADS, LDS_BYTES);
        (void)hipGetLastError();
        grid = cus * (per_cu >= 1 ? 1 : 1);
        if (grid != 256) fprintf(stderr, "kernel_launch: grid %d (expected 256)\n", grid);
    }
    if (grid < 0) return;
    Args a{};
    const float** p = (const float**)&a;
    for (int i = 0; i < 21; ++i) p[i] = (const float*)d_in[i];
    a.out = (float*)d_out; a.ws = (unsigned char*)d_ws; a.ph_lo = 0; a.ph_hi = NPH;
    void* args[] = {&a};
    hipError_t e = hipLaunchCooperativeKernel((const void*)mk_fwd, dim3(grid), dim3(NTHREADS), args, LDS_BYTES, stream);
    if (e != hipSuccess) fprintf(stderr, "cooperative launch failed: %s (grid %d)\n", hipGetErrorString(e), grid);
}
```

```cpp
#include <hip/hip_runtime.h>
#include <hip/hip_cooperative_groups.h>
#include <cstdio>
#include <cstdint>
namespace pg8 {
#define PG8_LAS __attribute__((address_space(3)))
typedef unsigned short bf16_t;
typedef short bf16x8 __attribute__((ext_vector_type(8)));
typedef float f32x4 __attribute__((ext_vector_type(4)));
typedef unsigned u32x4 __attribute__((ext_vector_type(4)));
constexpr int BM = 256, BK = 64, HALF = 128, HTB = HALF * BK * 2  , STAGE_BYTES = 8 * HTB, NXCD = 8, WGM = 8;

__host__ __device__ __forceinline__ int lds_byte(int r, int c) { const int st = (r >> 4) * 2 + (c >> 5), rr = r & 15, cc = c & 31, ob = rr * 64 + cc * 2; return st * 1024 + (ob ^ (((ob >> 9) & 1) << 5)); }
__host__ __device__ __forceinline__ void stage_rc(int b, int& R, int& C) { const int st = b / 1024, sb = b % 1024, swz = sb ^ (((sb >> 9) & 1) << 5); R = (st >> 1) * 16 + swz / 64; C = (st & 1) * 32 + (swz % 64) / 2; }
__host__ __device__ __forceinline__ int perm32(int rho) { const int n = rho >> 4, i = rho & 15; return 8 * (i >> 2) + 4 * n + (i & 3); }

struct Unit { int pm, pn; long aoff, boff; };
struct Gemm { const bf16_t* A; const bf16_t* Bt; int M, N, K, lda; };

struct StaticOrder {
    int nM, nN, nwg, G, c; long astep, bstep;
    __host__ __device__ void init(int M, int N, int K, int lda, int G_, int c_) { nM = M / BM; nN = N / BM; nwg = nM * nN; G = G_; c = c_; astep = (long)BM * lda * 2; bstep = (long)BM * K * 2; }
    __host__ __device__ bool next(int i, Unit& u) const {
        const long L = (long)i * G + c; if (L >= nwg) return false;
        int wgid = (int)L; { const int q = nwg / NXCD, r = nwg % NXCD, xcd = wgid % NXCD, off = wgid / NXCD; wgid = (xcd < r ? xcd * (q + 1) : r * (q + 1) + (xcd - r) * q) + off; }
        const int nig = WGM * nN, gid = wgid / nig, fm = gid * WGM, gsz = (nM - fm) < WGM ? (nM - fm) : WGM;
        u.pm = fm + ((wgid % nig) % gsz); u.pn = (wgid % nig) / gsz; u.aoff = u.pm * astep; u.boff = u.pn * bstep; return true;
    }
    __device__ __forceinline__ void a_ready(const Unit&) const {}
    __device__ __forceinline__ void done(const Unit&) const {}
};

__device__ __forceinline__ unsigned cvt_pk_bf16(float lo, float hi) { unsigned r; asm volatile("v_cvt_pk_bf16_f32 %0, %1, %2" : "=v"(r) : "v"(lo), "v"(hi)); return r; }
typedef float f32x2 __attribute__((ext_vector_type(2)));
__device__ __forceinline__ f32x2 gelu_pk(f32x2 v) {
    const f32x2 av = __builtin_elementwise_abs(v), d = av * 0.2316418882f + 1.0f;
    f32x2 t; t.x = __builtin_amdgcn_rcpf(d.x); t.y = __builtin_amdgcn_rcpf(d.y);
    f32x2 q = t * 0.5307027145f + (-0.7265760135f); q = q * t + 0.7107068705f; q = q * t + (-0.142248368f); q = q * t + 0.127414796f; q = q * t;
    const f32x2 s = (v * v) * (-0.72134752044f);
    f32x2 e; e.x = __builtin_amdgcn_exp2f(s.x); e.y = __builtin_amdgcn_exp2f(s.y);
    const f32x2 m = v * (q * e), r = v - m;
    f32x2 o; o.x = v.x < 0.f ? m.x : r.x; o.y = v.y < 0.f ? m.y : r.y; return o;
}

template <int ACT  > struct EpiBf16 {
    static constexpr bool PERM = true, AFTER_DRAIN = false; static_assert(ACT == 0 || ACT == 1, "EpiBf16: ACT is 0 (none) or 1 (gelu_pk)");
    bf16_t* O; int ldc; const float* bias; int split_cols; size_t split_stride; float scale0;
    __device__ __forceinline__ void operator()(const f32x4 (&acc)[2][2][4][2], const Unit& u, int wr, int wc, int fr, int fq) const {
        const int row0 = u.pm * BM + wr * 64 + fr; int colt = u.pn * BM; bf16_t* base = O;
        float sc = 1.f; if (split_cols) { const int t = colt / split_cols; base += (size_t)t * split_stride; colt -= t * split_cols; if (t == 0) sc = scale0; }
        const int col0 = colt + wc * 32 + 8 * fq, bcol0 = u.pn * BM + wc * 32 + 8 * fq;
        f32x4 bv[2][2];
#pragma unroll
        for (int bj = 0; bj < 2; ++bj)
#pragma unroll
            for (int n = 0; n < 2; ++n) bv[bj][n] = bias ? *(const f32x4*)(bias + bcol0 + bj * HALF + 4 * n) : (f32x4){0.f, 0.f, 0.f, 0.f};
#pragma unroll
        for (int ai = 0; ai < 2; ++ai)
#pragma unroll
            for (int m = 0; m < 4; ++m) { bf16_t* rowp = base + (size_t)(row0 + ai * HALF + m * 16) * ldc + col0;
#pragma unroll
                for (int bj = 0; bj < 2; ++bj) { f32x4 v0 = acc[ai][bj][m][0] + bv[bj][0], v1 = acc[ai][bj][m][1] + bv[bj][1];
                    if (ACT == 1) { f32x2 a = gelu_pk((f32x2){v0[0], v0[1]}), b = gelu_pk((f32x2){v0[2], v0[3]}), c = gelu_pk((f32x2){v1[0], v1[1]}), d = gelu_pk((f32x2){v1[2], v1[3]});
                        v0 = (f32x4){a.x, a.y, b.x, b.y}; v1 = (f32x4){c.x, c.y, d.x, d.y}; }
                    v0 = v0 * sc; v1 = v1 * sc; u32x4 w; w.x = cvt_pk_bf16(v0[0], v0[1]); w.y = cvt_pk_bf16(v0[2], v0[3]); w.z = cvt_pk_bf16(v1[0], v1[1]); w.w = cvt_pk_bf16(v1[2], v1[3]);
                    *(u32x4*)(rowp + bj * HALF) = w; } }
    }
};
constexpr int MREAL = 16384;
typedef unsigned u32x2e __attribute__((ext_vector_type(2)));
__device__ __forceinline__ float bf_lo(unsigned w) { return __uint_as_float(w << 16); }
__device__ __forceinline__ float bf_hi(unsigned w) { return __uint_as_float(w & 0xffff0000u); }
__device__ __forceinline__ float sigmoid_f(float x) { return __builtin_amdgcn_rcpf(1.f + __builtin_amdgcn_exp2f(-1.4426950408889634f * x)); }
struct EpiRes {
    static constexpr bool PERM = false, AFTER_DRAIN = false;
    float* hreal; float* hmeta; float alpha;
    __device__ __forceinline__ void operator()(const f32x4 (&acc)[2][2][4][2], const Unit& u, int wr, int wc, int fr, int fq) const {
        float* base = (u.pm < MREAL / BM) ? hreal + (size_t)u.pm * BM * 1024 : hmeta + (size_t)(u.pm - MREAL / BM) * BM * 1024;
        const int col0 = u.pn * BM + wc * 32 + 4 * fq;
#pragma unroll
        for (int ai = 0; ai < 2; ++ai)
#pragma unroll
            for (int m = 0; m < 4; ++m) { float* rowp = base + (size_t)(ai * HALF + wr * 64 + m * 16 + fr) * 1024 + col0;
#pragma unroll
                for (int bj = 0; bj < 2; ++bj)
#pragma unroll
                    for (int n = 0; n < 2; ++n) { f32x4* p = (f32x4*)(rowp + bj * HALF + n * 16); const f32x4 hv = *p; *p = hv * alpha + acc[ai][bj][m][n]; } }
    }
};
struct EpiGlu {
    static constexpr bool PERM = true, AFTER_DRAIN = false;
    const bf16_t* Gb; bf16_t* Z;
    __device__ __forceinline__ void operator()(const f32x4 (&acc)[2][2][4][2], const Unit& u, int wr, int wc, int fr, int fq) const {
        const int row0 = u.pm * BM + wr * 64 + fr, col0 = u.pn * BM + wc * 32 + 8 * fq;
#pragma unroll
        for (int ai = 0; ai < 2; ++ai)
#pragma unroll
            for (int m = 0; m < 4; ++m) { const size_t off = (size_t)(row0 + ai * HALF + m * 16) * 1024 + col0;
#pragma unroll
                for (int bj = 0; bj < 2; ++bj) { const u32x4 gv = *(const u32x4*)(Gb + off + bj * HALF); const f32x4 a0 = acc[ai][bj][m][0], a1 = acc[ai][bj][m][1]; u32x4 w;
                    w.x = cvt_pk_bf16(bf_lo(gv.x) * sigmoid_f(a0[0]), bf_hi(gv.x) * sigmoid_f(a0[1])); w.y = cvt_pk_bf16(bf_lo(gv.y) * sigmoid_f(a0[2]), bf_hi(gv.y) * sigmoid_f(a0[3]));
                    w.z = cvt_pk_bf16(bf_lo(gv.z) * sigmoid_f(a1[0]), bf_hi(gv.z) * sigmoid_f(a1[1])); w.w = cvt_pk_bf16(bf_lo(gv.w) * sigmoid_f(a1[2]), bf_hi(gv.w) * sigmoid_f(a1[3]));
                    *(u32x4*)(Z + off + bj * HALF) = w; } }
    }
};
struct EpiSwiGlu {
    static constexpr bool PERM = true, AFTER_DRAIN = false;
    bf16_t* FFo; int ldc;
    __device__ __forceinline__ void operator()(const f32x4 (&acc)[2][2][4][2], const Unit& u, int wr, int wc, int fr, int fq) const {
        const int row0 = u.pm * BM + wr * 64 + fr, col0 = u.pn * HALF + wc * 32 + 8 * fq;
#pragma unroll
        for (int ai = 0; ai < 2; ++ai)
#pragma unroll
            for (int m = 0; m < 4; ++m) { float o[8];
#pragma unroll
                for (int n = 0; n < 2; ++n)
#pragma unroll
                    for (int j = 0; j < 4; ++j) { const float gt = acc[ai][0][m][n][j], up = acc[ai][1][m][n][j]; o[n * 4 + j] = gt * sigmoid_f(gt) * up; }
                u32x4 w; w.x = cvt_pk_bf16(o[0], o[1]); w.y = cvt_pk_bf16(o[2], o[3]); w.z = cvt_pk_bf16(o[4], o[5]); w.w = cvt_pk_bf16(o[6], o[7]);
                *(u32x4*)(FFo + (size_t)(row0 + ai * HALF + m * 16) * ldc + col0) = w; }
    }
};
constexpr int S5_R = 1026;
struct EpiS5a {
    static constexpr bool PERM = false, AFTER_DRAIN = false;
    float* Sloc;
    __device__ __forceinline__ void operator()(const f32x4 (&acc)[2][2][4][2], const Unit& u, int wr, int wc, int fr, int fq) const {
        const int g = u.pn, rt = u.pm - 5 * g, col0 = wc * 32 + 4 * fq;
#pragma unroll
        for (int ai = 0; ai < 2; ++ai)
#pragma unroll
            for (int m = 0; m < 4; ++m) { const int rr = rt * BM + ai * HALF + wr * 64 + m * 16 + fr; if (rr < S5_R) { float* rowp = Sloc + ((size_t)g * S5_R + rr) * 256 + col0;
#pragma unroll
                for (int bj = 0; bj < 2; ++bj)
#pragma unroll
                    for (int n = 0; n < 2; ++n) *(f32x4*)(rowp + bj * HALF + n * 16) = acc[ai][bj][m][n]; } }
    }
};
struct EpiS5c {
    static constexpr bool PERM = true, AFTER_DRAIN = false;
    const float* hreal; const float* hmeta; const float* dskip; bf16_t* Gb;
    __device__ __forceinline__ void operator()(const f32x4 (&acc)[2][2][4][2], const Unit& u, int wr, int wc, int fr, int fq) const {
        const int g = u.pn, rt = u.pm - 5 * g, ch = 16 * g + 8 * (fq & 1);
        const f32x4 d0 = *(const f32x4*)(dskip + ch), d1 = *(const f32x4*)(dskip + ch + 4);
#pragma unroll
        for (int ai = 0; ai < 2; ++ai)
#pragma unroll
            for (int m = 0; m < 4; ++m) { const int rr = rt * BM + ai * HALF + wr * 64 + m * 16 + fr; if (rr < S5_R) {
#pragma unroll
                for (int bj = 0; bj < 2; ++bj) { const int t = 8 * bj + 2 * wc + (fq >> 1), tok = 16 * rr + t;
                    const float* hp = (tok < MREAL ? hreal + (size_t)tok * 1024 : hmeta + (size_t)(tok - MREAL) * 1024) + ch;
                    const f32x4 h0 = *(const f32x4*)hp, h1 = *(const f32x4*)(hp + 4);
                    const f32x4 y0 = acc[ai][bj][m][0] + d0 * h0, y1 = acc[ai][bj][m][1] + d1 * h1;
                    const f32x2 a = gelu_pk((f32x2){y0[0], y0[1]}), b = gelu_pk((f32x2){y0[2], y0[3]}), c = gelu_pk((f32x2){y1[0], y1[1]}), e = gelu_pk((f32x2){y1[2], y1[3]});
                    u32x4 w; w.x = cvt_pk_bf16(a.x, a.y); w.y = cvt_pk_bf16(b.x, b.y); w.z = cvt_pk_bf16(c.x, c.y); w.w = cvt_pk_bf16(e.x, e.y);
                    *(u32x4*)(Gb + (size_t)tok * 1024 + ch) = w; } } }
    }
};
struct S5Order {
    int G, c; long arow_bytes, brow_bytes;
    __device__ __forceinline__ bool next(int i, Unit& u) const { const int L = i * G + c; if (L >= 320) return false; const int g = L / 5, rt = L - 5 * g;
        u.pm = L; u.pn = g; u.aoff = ((long)g * S5_R + rt * BM) * arow_bytes; u.boff = (long)g * BM * brow_bytes; return true; }
    __device__ __forceinline__ void a_ready(const Unit&) const {}
    __device__ __forceinline__ void done(const Unit&) const {}
};
template <class Epi, class Sched, bool ALIGN_EPI = false, bool SP2 = false>
__device__ __forceinline__ void gemm_phase(PG8_LAS unsigned char* lds, const Gemm g, const Sched& S, const Epi& E) {
    const int tid = threadIdx.x, wid = __builtin_amdgcn_readfirstlane(tid >> 6), lane = tid & 63, wr = wid >> 2, wc = wid & 3, fr = lane & 15, fq = lane >> 4;
    const int K = g.K, nt = K / BK;
    unsigned voffA[2], voffB[2];
#pragma unroll
    for (int i = 0; i < 2; ++i) { int R, C; stage_rc(tid * 16 + i * 8192, R, C); const int Rb = Epi::PERM ? ((R & ~31) + perm32(R & 31)) : R;
        voffA[i] = (unsigned)(R * g.lda + C) * 2u; voffB[i] = (unsigned)(Rb * K + C) * 2u; }
    const size_t kstep = (size_t)(BK * 2);
    const size_t hstepA = (size_t)HALF * g.lda * 2, hstepB = (size_t)HALF * K * 2;
    const unsigned ldsw = (unsigned)wid * 1024u;
    const int aoff = lds_byte(wr * 64 + fr, fq * 8), boff = lds_byte(wc * 32 + fr, fq * 8);
#define PG8_SA(b, h) (((b) * 2 + (h)) * HTB)
#define PG8_SB(b, h) ((4 + (b) * 2 + (h)) * HTB)
#define PG8_STAGE(bufoff, gbase, voff) do { _Pragma("unroll") for (int _i = 0; _i < 2; ++_i) \
        __builtin_amdgcn_global_load_lds((const unsigned*)((const char*)(gbase) + (voff)[_i]), (PG8_LAS unsigned*)(lds + (bufoff) + ldsw + _i * 8192), 16, 0, 0); } while (0)
#define PG8_LDA(dst, b, h) do { _Pragma("unroll") for (int m = 0; m < 4; ++m) _Pragma("unroll") for (int k = 0; k < 2; ++k) dst[m][k] = *(const PG8_LAS bf16x8*)(lds + PG8_SA(b, h) + aoff + m * 2048 + k * 1024); } while (0)
#define PG8_LDB(dst, b, h) do { _Pragma("unroll") for (int n = 0; n < 2; ++n) _Pragma("unroll") for (int k = 0; k < 2; ++k) dst[n][k] = *(const PG8_LAS bf16x8*)(lds + PG8_SB(b, h) + boff + n * 2048 + k * 1024); } while (0)
#define PG8_MMA(ai, bj, At, Bt) do { __builtin_amdgcn_s_setprio(1); _Pragma("unroll") for (int m = 0; m < 4; ++m) _Pragma("unroll") for (int n = 0; n < 2; ++n) _Pragma("unroll") for (int k = 0; k < 2; ++k) \
        acc[ai][bj][m][n] = __builtin_amdgcn_mfma_f32_16x16x32_bf16(Bt[n][k], At[m][k], acc[ai][bj][m][n], 0, 0, 0); __builtin_amdgcn_s_setprio(0); } while (0)
#define PG8_WAIT_V(n) asm volatile("s_waitcnt vmcnt(" #n ")" ::: "memory")
#define PG8_WAIT_L(n) asm volatile("s_waitcnt lgkmcnt(" #n ")" ::: "memory")
#define PG8_BAR __builtin_amdgcn_s_barrier()
#define PG8_SCHED __builtin_amdgcn_sched_barrier(0)
    Unit cur, nxt; int ui = 0;
    if (!S.next(0, cur)) return;
    f32x4 acc[2][2][4][2];
#pragma unroll
    for (int a = 0; a < 2; ++a)
#pragma unroll
        for (int b = 0; b < 2; ++b)
#pragma unroll
            for (int m = 0; m < 4; ++m)
#pragma unroll
                for (int n = 0; n < 2; ++n) acc[a][b][m][n] = (f32x4){0.f, 0.f, 0.f, 0.f};
    bf16x8 At[4][2], B0[2][2], B1[2][2];
    const char* cA = (const char*)g.A + cur.aoff; const char* cB = (const char*)g.Bt + cur.boff;
    S.a_ready(cur);
    if constexpr (SP2) {
        PG8_STAGE(PG8_SB(0, 0), cB, voffB); PG8_STAGE(PG8_SB(0, 1), cB + hstepB, voffB); PG8_STAGE(PG8_SA(0, 0), cA, voffA); PG8_STAGE(PG8_SA(0, 1), cA + hstepA, voffA);
        if (wr == 1) PG8_BAR;
        PG8_WAIT_V(2); PG8_BAR;
        PG8_STAGE(PG8_SB(1, 0), cB + kstep, voffB); PG8_STAGE(PG8_SA(1, 0), cA + kstep, voffA); PG8_STAGE(PG8_SB(1, 1), cB + hstepB + kstep, voffB);
        PG8_WAIT_V(6); PG8_BAR;
    } else {
        PG8_STAGE(PG8_SB(0, 0), cB, voffB); PG8_STAGE(PG8_SA(0, 0), cA, voffA); PG8_STAGE(PG8_SB(0, 1), cB + hstepB, voffB); PG8_STAGE(PG8_SA(0, 1), cA + hstepA, voffA);
        if (wr == 1) PG8_BAR;
        PG8_WAIT_V(4); PG8_BAR;
        PG8_STAGE(PG8_SB(1, 0), cB + kstep, voffB); PG8_STAGE(PG8_SA(1, 0), cA + kstep, voffA); PG8_STAGE(PG8_SB(1, 1), cB + hstepB + kstep, voffB);
        PG8_WAIT_V(6); PG8_BAR;
    }
    for (;;) {
        const bool has_next = S.next(ui + 1, nxt);
        const char* nA = has_next ? (const char*)g.A + nxt.aoff : cA; const char* nB = has_next ? (const char*)g.Bt + nxt.boff : cB;
        for (int t = 0; t < nt; t += 2) {
            const bool last = (t == nt - 2);
            const char* a1 = cA + (size_t)(t + 1) * kstep;
            const char* a2 = last ? nA : cA + (size_t)(t + 2) * kstep; const char* b2 = last ? nB : cB + (size_t)(t + 2) * kstep;
            const char* a3 = a2 + kstep; const char* b3 = b2 + kstep;
            if (last && has_next) S.a_ready(nxt);
            if constexpr (SP2) {
            PG8_LDB(B0, 0, 0); PG8_LDB(B1, 0, 1); PG8_SCHED; PG8_LDA(At, 0, 0); PG8_STAGE(PG8_SA(1, 1), a1 + hstepA, voffA);
            PG8_WAIT_V(8); PG8_WAIT_L(0); PG8_BAR; PG8_MMA(0, 0, At, B0); PG8_MMA(0, 1, At, B1); PG8_BAR; PG8_SCHED;
            PG8_LDA(At, 0, 1); PG8_STAGE(PG8_SB(0, 0), b2, voffB); PG8_STAGE(PG8_SB(0, 1), b2 + hstepB, voffB); PG8_STAGE(PG8_SA(0, 0), a2, voffA);
            PG8_WAIT_V(8); PG8_WAIT_L(0); PG8_BAR; PG8_MMA(1, 0, At, B0); PG8_MMA(1, 1, At, B1); PG8_BAR; PG8_SCHED;
            PG8_LDB(B0, 1, 0); PG8_LDB(B1, 1, 1); PG8_SCHED; PG8_LDA(At, 1, 0); PG8_STAGE(PG8_SA(0, 1), a2 + hstepA, voffA);
            PG8_WAIT_V(8); PG8_WAIT_L(0); PG8_BAR; PG8_MMA(0, 0, At, B0); PG8_MMA(0, 1, At, B1); PG8_BAR; PG8_SCHED;
            PG8_LDA(At, 1, 1); PG8_STAGE(PG8_SB(1, 0), b3, voffB); PG8_STAGE(PG8_SB(1, 1), b3 + hstepB, voffB); PG8_STAGE(PG8_SA(1, 0), a3, voffA);
            PG8_WAIT_V(8); PG8_WAIT_L(0); PG8_BAR; PG8_MMA(1, 0, At, B0); PG8_MMA(1, 1, At, B1); PG8_BAR; PG8_SCHED;
            } else {
            PG8_LDB(B0, 0, 0); PG8_SCHED; PG8_LDA(At, 0, 0); PG8_STAGE(PG8_SA(1, 1), a1 + hstepA, voffA);
            PG8_WAIT_L(8); PG8_BAR; PG8_WAIT_L(0); PG8_MMA(0, 0, At, B0); PG8_BAR; PG8_SCHED;
            PG8_LDB(B1, 0, 1); PG8_STAGE(PG8_SB(0, 0), b2, voffB);
            PG8_BAR; PG8_WAIT_L(0); PG8_MMA(0, 1, At, B1); PG8_BAR;
            PG8_LDA(At, 0, 1); PG8_STAGE(PG8_SA(0, 0), a2, voffA);
            PG8_BAR; PG8_WAIT_L(0); PG8_MMA(1, 0, At, B0); PG8_BAR; PG8_SCHED;
            PG8_STAGE(PG8_SB(0, 1), b2 + hstepB, voffB);
            PG8_WAIT_V(6); PG8_BAR; PG8_MMA(1, 1, At, B1); PG8_BAR;
            PG8_LDB(B0, 1, 0); PG8_SCHED; PG8_LDA(At, 1, 0); PG8_STAGE(PG8_SA(0, 1), a2 + hstepA, voffA);
            PG8_WAIT_L(8); PG8_BAR; PG8_WAIT_L(0); PG8_MMA(0, 0, At, B0); PG8_BAR; PG8_SCHED;
            PG8_LDB(B1, 1, 1); PG8_STAGE(PG8_SB(1, 0), b3, voffB);
            PG8_BAR; PG8_WAIT_L(0); PG8_MMA(0, 1, At, B1); PG8_BAR;
            PG8_LDA(At, 1, 1); PG8_STAGE(PG8_SA(1, 0), a3, voffA);
            PG8_BAR; PG8_WAIT_L(0); PG8_MMA(1, 0, At, B0); PG8_BAR; PG8_SCHED;
            PG8_STAGE(PG8_SB(1, 1), b3 + hstepB, voffB);
            PG8_WAIT_V(6); PG8_BAR; PG8_MMA(1, 1, At, B1); PG8_BAR;
            }
        }
        if constexpr (ALIGN_EPI) { if (wr == 0) PG8_BAR; }
        if constexpr (!Epi::AFTER_DRAIN) { E(acc, cur, wr, wc, fr, fq); S.done(cur); }
        if (!has_next) break;
#pragma unroll
        for (int a = 0; a < 2; ++a)
#pragma unroll
            for (int b = 0; b < 2; ++b)
#pragma unroll
                for (int m = 0; m < 4; ++m)
#pragma unroll
                    for (int n = 0; n < 2; ++n) acc[a][b][m][n] = (f32x4){0.f, 0.f, 0.f, 0.f};
        cur = nxt; cA = nA; cB = nB; ++ui;
        if constexpr (ALIGN_EPI) { if (wr == 1) PG8_BAR; }
    }
    PG8_WAIT_V(0);
    if constexpr (!ALIGN_EPI) { if (wr == 0) PG8_BAR; }
    PG8_BAR;
    if constexpr (Epi::AFTER_DRAIN) { E.fused(acc, cur, wr, wc, fr, fq, lds, wid, lane); S.done(cur); }
#undef PG8_SA
#undef PG8_SB
#undef PG8_STAGE
#undef PG8_LDA
#undef PG8_LDB
#undef PG8_MMA
#undef PG8_WAIT_V
#undef PG8_WAIT_L
#undef PG8_BAR
#undef PG8_SCHED
}
}

#ifndef PG8_SP2
#define PG8_SP2 true
#endif
#ifndef PG8_ALIGN
#define PG8_ALIGN true
#endif
#include <hip/hip_bf16.h>
#include <cmath>
namespace attn_body {
using bf16=__hip_bfloat16;
using bf16x8=__attribute__((ext_vector_type(8)))short;
using s16x4=__attribute__((ext_vector_type(4)))short;
using f32x16=__attribute__((ext_vector_type(16)))float;
using u32x4=__attribute__((ext_vector_type(4)))unsigned;
constexpr int NHEAD=16,D=64,PQ=1536,PO=1024,NT=130;
constexpr int NW=8,QBLK=32,QB=QBLK*NW,KVBLK=64;
__device__ __forceinline__ int crow(int r,int hi){return (r&3)+8*(r>>2)+4*hi;}
#define SBAR() __builtin_amdgcn_sched_barrier(0)
constexpr int NSLOT=3, SLOTB=8192;
constexpr int LDS_K=0, LDS_V=NSLOT*SLOTB, LDS_WS=2*NSLOT*SLOTB, LDS_OST=LDS_WS+NW*64*4, LDS_BYTES=LDS_OST+NW*4096;
constexpr float C2=0.125f*1.4426950408889634f;
__device__ __forceinline__ void glds16(const void*gsrc,unsigned lds_dst){unsigned keep;
  asm volatile("s_mov_b32 %0, m0\n\ts_mov_b32 m0, %2\n\ts_nop 0\n\tglobal_load_lds_dwordx4 %1, off\n\ts_mov_b32 m0, %0":"=&s"(keep):"v"(gsrc),"s"(lds_dst):"memory");}
__device__ __forceinline__ float max3f(float a,float b,float c){float r;asm("v_max3_f32 %0, %1, %2, %3":"=v"(r):"v"(a),"v"(b),"v"(c));return r;}
__device__ __forceinline__ float max2f(float a,float b){float r;asm("v_max_f32_e32 %0, %1, %2":"=v"(r):"v"(a),"v"(b));return r;}
__device__ __forceinline__ float fadd_s(float a,float b){float r;asm("v_add_f32_e32 %0, %1, %2":"=v"(r):"v"(a),"v"(b));return r;}
__device__ __forceinline__ float fsub_s(float a,float b){float r;asm("v_sub_f32_e32 %0, %1, %2":"=v"(r):"v"(a),"v"(b));return r;}
typedef float f32x2_t __attribute__((ext_vector_type(2))); typedef __bf16 bf16x2_t __attribute__((ext_vector_type(2)));
__device__ __forceinline__ unsigned cvtpk_s(float lo,float hi){f32x2_t v={lo,hi};bf16x2_t b=__builtin_convertvector(v,bf16x2_t);return __builtin_bit_cast(unsigned,b);}
#define WAIT_BAR(N) asm volatile("s_waitcnt vmcnt(" #N ") lgkmcnt(0)\n\ts_barrier":::"memory")

__device__ __forceinline__ void qkt(f32x16&p0,f32x16&p1,const char*Kslot,const bf16x8*qr,const f32x16&negm,int r32,int hi){
  const char*kb=Kslot+hi*1024+r32*16;
  #pragma unroll
  for(int d0=0;d0<4;++d0){
    const bf16x8 b0=*reinterpret_cast<const bf16x8*>(kb+d0*2048);
    const bf16x8 b1=*reinterpret_cast<const bf16x8*>(kb+d0*2048+512);
    if(d0==0){p0=__builtin_amdgcn_mfma_f32_32x32x16_bf16(b0,qr[0],negm,0,0,0);p1=__builtin_amdgcn_mfma_f32_32x32x16_bf16(b1,qr[0],negm,0,0,0);}
    else{p0=__builtin_amdgcn_mfma_f32_32x32x16_bf16(b0,qr[d0],p0,0,0,0);p1=__builtin_amdgcn_mfma_f32_32x32x16_bf16(b1,qr[d0],p1,0,0,0);}}
}
typedef __attribute__((address_space(3))) const char* lds_cptr;
typedef short v4i16_t __attribute__((ext_vector_type(4)));
__device__ __forceinline__ void kload8(bf16x8*kf,lds_cptr kp){
  kf[0]=*(const __attribute__((address_space(3))) bf16x8*)(kp);      kf[1]=*(const __attribute__((address_space(3))) bf16x8*)(kp+512);
  kf[2]=*(const __attribute__((address_space(3))) bf16x8*)(kp+2048); kf[3]=*(const __attribute__((address_space(3))) bf16x8*)(kp+2560);
  kf[4]=*(const __attribute__((address_space(3))) bf16x8*)(kp+4096); kf[5]=*(const __attribute__((address_space(3))) bf16x8*)(kp+4608);
  kf[6]=*(const __attribute__((address_space(3))) bf16x8*)(kp+6144); kf[7]=*(const __attribute__((address_space(3))) bf16x8*)(kp+6656);
}
__device__ __forceinline__ void kload2(bf16x8*kf,lds_cptr kp,int j){ kf[2*j]=*(const __attribute__((address_space(3))) bf16x8*)(kp+j*2048); kf[2*j+1]=*(const __attribute__((address_space(3))) bf16x8*)(kp+j*2048+512); }
__device__ __forceinline__ s16x4 vtr(lds_cptr p){ return __builtin_bit_cast(s16x4,__builtin_amdgcn_ds_read_tr16_b64_v4i16((__attribute__((address_space(3))) v4i16_t*)p)); }
__device__ __forceinline__ float rowmax(const f32x16&p0,const f32x16&p1){
  float a=max3f(p0[0],p0[1],p1[0]),b=max3f(p0[2],p0[3],p1[1]);a=max3f(a,p1[2],p1[3]);
  #pragma unroll
  for(int r=4;r<16;r+=4){a=max3f(a,p0[r],p0[r+1]);b=max3f(b,p0[r+2],p0[r+3]);a=max3f(a,p1[r],p1[r+1]);b=max3f(b,p1[r+2],p1[r+3]);}
  const float m=max2f(a,b);
  auto rr=__builtin_amdgcn_permlane32_swap(__float_as_uint(m),__float_as_uint(m),false,false);
  return max2f(__uint_as_float(rr[0]),__uint_as_float(rr[1]));
}
__device__ __forceinline__ void pv(f32x16*o,int vb,bf16x8 pa0,bf16x8 pa1,bf16x8 pa2,bf16x8 pa3){
  #pragma unroll
  for(int d0=0;d0<2;++d0){s16x4 lo[4],hi[4];
    #pragma unroll
    for(int ks=0;ks<4;++ks){
      asm volatile("ds_read_b64_tr_b16 %0,%1 offset:%c2":"=&v"(lo[ks]):"v"(vb),"i"(d0*4096+ks*1024):"memory");
      asm volatile("ds_read_b64_tr_b16 %0,%1 offset:%c2":"=&v"(hi[ks]):"v"(vb),"i"(d0*4096+ks*1024+512):"memory");}
    asm volatile("s_waitcnt lgkmcnt(0)":::"memory");SBAR();
    #define PK(k) (bf16x8){lo[k][0],lo[k][1],lo[k][2],lo[k][3],hi[k][0],hi[k][1],hi[k][2],hi[k][3]}
    o[d0]=__builtin_amdgcn_mfma_f32_32x32x16_bf16(pa0,PK(0),o[d0],0,0,0);
    o[d0]=__builtin_amdgcn_mfma_f32_32x32x16_bf16(pa1,PK(1),o[d0],0,0,0);
    o[d0]=__builtin_amdgcn_mfma_f32_32x32x16_bf16(pa2,PK(2),o[d0],0,0,0);
    o[d0]=__builtin_amdgcn_mfma_f32_32x32x16_bf16(pa3,PK(3),o[d0],0,0,0);
    #undef PK
  }
}

#ifndef ATTN_STORE16
#define ATTN_STORE16(p,v) (*(u32x4*)(p)=(v))
#endif
__device__ __forceinline__ void tmask(f32x16&p0,f32x16&p1,bool full){ const float NEG=-INFINITY;
  #pragma unroll
  for(int r=0;r<16;++r){ p1[r]=NEG; if(full||r>=8)p0[r]=NEG; } }
template<int THRL> __device__ __forceinline__ void attn_unit(const bf16*Q0,const bf16*__restrict__ Kh,const bf16*__restrict__ Vh,long metarow,bf16*O0,int nvalid,char*shm){
  const int tid=threadIdx.x,lane=tid&63,r32=lane&31,hi=lane>>5; const int wid=__builtin_amdgcn_readfirstlane(tid>>6);
  const bf16*Qw=Q0+(long)(wid*QBLK)*PQ;
  const unsigned lds0=(unsigned)(uintptr_t)shm;
  float*wsf=(float*)(shm+LDS_WS)+wid*64;
  const bf16*ksrc=Kh+(long)lane*PQ+wid*8;
  const bf16*vsrc=Vh+(long)(16*(wid&3)+(lane>>2))*PQ+(wid>>2)*32+(lane&3)*8;
  const unsigned kdst=lds0+LDS_K+wid*1024, vdst=lds0+LDS_V+wid*1024;
  #define TOFF(t) (((t)<NT-2?(long)(t)*KVBLK:metarow)*PQ)
  #define DMA_K(t,slot) glds16(ksrc+TOFF(t),(unsigned)__builtin_amdgcn_readfirstlane(kdst+(slot)))
  #define DMA_V(t,slot) glds16(vsrc+TOFF(t),(unsigned)__builtin_amdgcn_readfirstlane(vdst+(slot)))
  const int vb0=(int)(lds0+LDS_V)+((lane>>4)&1)*32+(lane&3)*8+(4*hi+((lane&15)>>2))*64;
  const char*Kbase=shm+LDS_K; bf16x8 kf[8];
  const lds_cptr shm3=(lds_cptr)shm; const lds_cptr kp0=shm3+LDS_K+hi*1024+r32*16; const lds_cptr vp0=shm3+LDS_V+((lane>>4)&1)*32+(lane&3)*8+(4*hi+((lane&15)>>2))*64;
  DMA_K(0,0);DMA_V(0,0);DMA_K(1,SLOTB);
  bf16x8 qr[4];
  #pragma unroll
  for(int d0=0;d0<4;++d0)qr[d0]=*reinterpret_cast<const bf16x8*>(&Qw[(long)r32*PQ+d0*16+hi*8]);
  float mhat=0.f,l_reg=0.f;f32x16 o[2];o[0]=f32x16{};o[1]=f32x16{};f32x16 negm=f32x16{};asm volatile("":"+v"(negm));
  #define CMASK(P0,P1,t) do{ if((t)>=NT-2) tmask(P0,P1,(t)==NT-1); }while(0)
  bool resc=false;
  #define START(P0,P1) do{ const float rm=rowmax(P0,P1); resc=false; \
    { const float dl=rm; mhat=fadd_s(mhat,dl); \
      _Pragma("unroll") for(int r=0;r<16;++r){P0[r]=fsub_s(P0[r],dl);P1[r]=fsub_s(P1[r],dl);} \
      _Pragma("unroll") for(int r=0;r<16;++r)negm[r]=-mhat; asm volatile("":"+v"(negm)); } \
    _Pragma("unroll") for(int r=0;r<16;++r)P0[r]=__builtin_amdgcn_exp2f(P0[r]); }while(0)
  #define RESC() do{ if(resc){ asm volatile("s_waitcnt lgkmcnt(0)":::"memory"); \
      _Pragma("unroll") for(int d_=0;d_<2;++d_) _Pragma("unroll") for(int r=0;r<16;++r)o[d_][r]*=wsf[crow(r,hi)]; } }while(0)
  f32x16 pA0,pA1,pB0,pB1;
  int sl_prev=0,sl_cur=0,sl_next=SLOTB;
  #define ROT() do{sl_prev=sl_cur;sl_cur=sl_next;sl_next=(sl_next==(NSLOT-1)*SLOTB)?0:sl_next+SLOTB;}while(0)
  DMA_K(2,2*SLOTB);
  WAIT_BAR(3);
  qkt(pA0,pA1,Kbase,qr,negm,r32,hi);asm volatile("s_nop 15\n\ts_nop 7":"+v"(pA0),"+v"(pA1));CMASK(pA0,pA1,0);
  START(pA0,pA1);
  _Pragma("unroll") for(int r=0;r<16;++r)pA1[r]=__builtin_amdgcn_exp2f(pA1[r]);
  WAIT_BAR(0);
  DMA_K(3,0);DMA_V(1,SLOTB);
  ROT();
  kload8(kf,kp0+sl_cur);
  WAIT_BAR(2);
  s16x4 vlo[8],vhi[8]; u32x4 pw0,pw1,pw2,pw3;
  #define PKW(P,B) cvtpk_s(P[B],P[B+1])
  #define PAF(k) __builtin_bit_cast(bf16x8,pw##k)
  #define VFR(i) (bf16x8){vlo[i][0],vlo[i][1],vlo[i][2],vlo[i][3],vhi[i][0],vhi[i][1],vhi[i][2],vhi[i][3]}
  #define PIN(x) asm volatile("":"+v"(x))
  #define MX3(a,b,c) __builtin_fmaxf(__builtin_fmaxf((a),(b)),(c))
  #define GAPA(MF,A0,A1,A2,A3,W0,W1,PW) do{ MF; sacc+=A0; sacc+=A1; sacc+=A2; sacc+=A3; PIN(sacc); W0; W1; PIN(PW); SBAR(); }while(0)
  #define EX(v) __builtin_amdgcn_exp2f(v)
  #define GAPB(MF,X,B) do{ MF; X[B]=EX(X[B]); X[B+1]=EX(X[B+1]); X[B+2]=EX(X[B+2]); X[B+3]=EX(X[B+3]); PIN(X); SBAR(); }while(0)
  #define VRD(i) do{ vlo[i]=vtr(vp_+(((i)>>2)*4096+((i)&3)*1024)); vhi[i]=vtr(vp_+(((i)>>2)*4096+((i)&3)*1024+512)); }while(0)
  #define KRD(G,j) do{ if(G){ kload2(kf,kp0+sl_next,j); SBAR(); } }while(0)
  #define STEP(C0,C1,P0,P1,t,GK,GV,GL) do{ SBAR(); \
    const lds_cptr vp_=vp0+sl_prev; \
    VRD(0); SBAR(); float sacc=(P0[0]+P0[1]); \
    GAPA(C0=__builtin_amdgcn_mfma_f32_32x32x16_bf16(kf[0],qr[0],negm,0,0,0), P0[2],P0[3],P0[4],P0[5],     pw0[0]=PKW(P0,0), pw0[1]=PKW(P0,2), pw0); \
    VRD(4); SBAR(); GAPA(C1=__builtin_amdgcn_mfma_f32_32x32x16_bf16(kf[1],qr[0],negm,0,0,0), P0[6],P0[7],P0[8],P0[9],     pw0[2]=PKW(P0,4), pw0[3]=PKW(P0,6), pw0); \
    VRD(1); SBAR(); GAPA(C0=__builtin_amdgcn_mfma_f32_32x32x16_bf16(kf[2],qr[1],C0,0,0,0),   P0[10],P0[11],P0[12],P0[13], pw1[0]=PKW(P0,8), pw1[1]=PKW(P0,10), pw1); \
    VRD(5); SBAR(); GAPA(C1=__builtin_amdgcn_mfma_f32_32x32x16_bf16(kf[3],qr[1],C1,0,0,0),   P0[14],P0[15],P1[0],P1[1],   pw1[2]=PKW(P0,12),pw1[3]=PKW(P0,14), pw1); \
    VRD(2); SBAR(); GAPA(C0=__builtin_amdgcn_mfma_f32_32x32x16_bf16(kf[4],qr[2],C0,0,0,0),   P1[2],P1[3],P1[4],P1[5],     pw2[0]=PKW(P1,0), pw2[1]=PKW(P1,2), pw2); \
    VRD(6); SBAR(); GAPA(C1=__builtin_amdgcn_mfma_f32_32x32x16_bf16(kf[5],qr[2],C1,0,0,0),   P1[6],P1[7],P1[8],P1[9],     pw2[2]=PKW(P1,4), pw2[3]=PKW(P1,6), pw2); \
    VRD(3); SBAR(); GAPA(C0=__builtin_amdgcn_mfma_f32_32x32x16_bf16(kf[6],qr[3],C0,0,0,0),   P1[10],P1[11],P1[12],P1[13], pw3[0]=PKW(P1,8), pw3[1]=PKW(P1,10), pw3); \
    VRD(7); SBAR(); GAPA(C1=__builtin_amdgcn_mfma_f32_32x32x16_bf16(kf[7],qr[3],C1,0,0,0),   P1[14],P1[15],0.f,0.f,       pw3[2]=PKW(P1,12),pw3[3]=PKW(P1,14), pw3); \
    l_reg+=sacc; \
    if(GK){DMA_K((t)+3,sl_cur);} if(GV){DMA_V((t)+1,sl_next);} \
    CMASK(C0,C1,t); \
    { float a=MX3(C0[0],C0[1],C1[0]),b=MX3(C0[2],C0[3],C1[1]); a=MX3(a,C1[2],C1[3]); \
      _Pragma("unroll") for(int r=4;r<16;r+=4){a=MX3(a,C0[r],C0[r+1]);b=MX3(b,C0[r+2],C0[r+3]);a=MX3(a,C1[r],C1[r+1]);b=MX3(b,C1[r+2],C1[r+3]);} \
      float rm=__builtin_fmaxf(a,b); { auto rr=__builtin_amdgcn_permlane32_swap(__float_as_uint(rm),__float_as_uint(rm),false,false); rm=__builtin_fmaxf(__uint_as_float(rr[0]),__uint_as_float(rr[1])); } \
      resc=false; \
      if(__builtin_expect(__any(rm>(float)THRL),0)){ const float dl=__builtin_fmaxf(rm,0.f); mhat+=dl; \
        _Pragma("unroll") for(int r=0;r<16;++r){C0[r]-=dl;C1[r]-=dl;} \
        _Pragma("unroll") for(int r=0;r<16;++r)negm[r]=-mhat; asm volatile("":"+v"(negm)); \
        const float f=__builtin_amdgcn_exp2f(-dl); l_reg*=f; if(hi==0)wsf[r32]=f; resc=true; } } \
    SBAR(); \
    GAPB(o[0]=__builtin_amdgcn_mfma_f32_32x32x16_bf16(PAF(0),VFR(0),o[0],0,0,0), C0,0); \
    GAPB(o[1]=__builtin_amdgcn_mfma_f32_32x32x16_bf16(PAF(0),VFR(4),o[1],0,0,0), C0,4); \
    KRD(GL,0); GAPB(o[0]=__builtin_amdgcn_mfma_f32_32x32x16_bf16(PAF(1),VFR(1),o[0],0,0,0), C0,8); \
    KRD(GL,1); GAPB(o[1]=__builtin_amdgcn_mfma_f32_32x32x16_bf16(PAF(1),VFR(5),o[1],0,0,0), C0,12); \
    KRD(GL,2); GAPB(o[0]=__builtin_amdgcn_mfma_f32_32x32x16_bf16(PAF(2),VFR(2),o[0],0,0,0), C1,0); \
    KRD(GL,3); GAPB(o[1]=__builtin_amdgcn_mfma_f32_32x32x16_bf16(PAF(2),VFR(6),o[1],0,0,0), C1,4); \
    GAPB(o[0]=__builtin_amdgcn_mfma_f32_32x32x16_bf16(PAF(3),VFR(3),o[0],0,0,0), C1,8); \
    GAPB(o[1]=__builtin_amdgcn_mfma_f32_32x32x16_bf16(PAF(3),VFR(7),o[1],0,0,0), C1,12); \
    }while(0)
  int t=1;
  #undef CMASK
  #define CMASK(P0,P1,t) do{}while(0)
  for(;t+5<NT;t+=2){
    STEP(pB0,pB1,pA0,pA1,t,true,true,true);     WAIT_BAR(2); RESC(); ROT();
    STEP(pA0,pA1,pB0,pB1,t+1,true,true,true);   WAIT_BAR(2); RESC(); ROT();
  }
  #undef CMASK
  #define CMASK(P0,P1,t) do{ if((t)>=NT-2) tmask(P0,P1,(t)==NT-1); }while(0)
  #define ENDW(tt) do{ if((tt)+3<NT){WAIT_BAR(2);} else if((tt)+2<NT){WAIT_BAR(1);} else {WAIT_BAR(0);} }while(0)
  for(;t+1<NT;t+=2){
    STEP(pB0,pB1,pA0,pA1,t,(t+3<NT),(t+1<NT),(t+1<NT));       ENDW(t);   RESC(); ROT();
    STEP(pA0,pA1,pB0,pB1,t+1,(t+4<NT),(t+2<NT),(t+2<NT));     ENDW(t+1); RESC(); ROT();
  }
  STEP(pB0,pB1,pA0,pA1,NT-1,false,false,false); RESC();
  { float sacc=pB0[0]+pB0[1]; _Pragma("unroll") for(int r=2;r<16;++r)sacc+=pB0[r]; _Pragma("unroll") for(int r=0;r<16;++r)sacc+=pB1[r]; l_reg+=sacc;
    pw0=(u32x4){PKW(pB0,0),PKW(pB0,2),PKW(pB0,4),PKW(pB0,6)};pw1=(u32x4){PKW(pB0,8),PKW(pB0,10),PKW(pB0,12),PKW(pB0,14)};pw2=(u32x4){PKW(pB1,0),PKW(pB1,2),PKW(pB1,4),PKW(pB1,6)};pw3=(u32x4){PKW(pB1,8),PKW(pB1,10),PKW(pB1,12),PKW(pB1,14)};
    SBAR(); pv(o,vb0+sl_cur,PAF(0),PAF(1),PAF(2),PAF(3)); }
  #undef PKW
  #undef PAF
  #undef VFR
  #undef PIN
  #undef MX3
  #undef GAPA
  #undef GAPB
  #undef EX
  #undef VRD
  #undef KRD
  #undef STEP
  #undef ENDW
  {auto rr=__builtin_amdgcn_permlane32_swap(__float_as_uint(l_reg),__float_as_uint(l_reg),false,false);l_reg=__uint_as_float(rr[0])+__uint_as_float(rr[1]);}
  if(hi==0)wsf[32+r32]=l_reg;asm volatile("s_waitcnt lgkmcnt(0)":::"memory");
  float rli[16];
  #pragma unroll
  for(int r=0;r<16;++r)rli[r]=__builtin_amdgcn_rcpf(wsf[32+crow(r,hi)]);
  bf16*Ow=O0+(long)(wid*QBLK)*PO;
  { bf16*stg=(bf16*)(shm+LDS_OST)+wid*2048;
    #pragma unroll
    for(int r=0;r<16;++r){const int orow=crow(r,hi);
      #pragma unroll
      for(int d0=0;d0<2;++d0)stg[orow*64+d0*32+r32]=__float2bfloat16(o[d0][r]*rli[r]);}
    asm volatile("s_waitcnt lgkmcnt(0)":::"memory");
    #pragma unroll
    for(int i=0;i<4;++i){const int row=i*8+(lane>>3),ch=lane&7; const u32x4 v=*(const u32x4*)(stg+row*64+ch*8); if(wid*QBLK+row<nvalid)ATTN_STORE16(Ow+(long)row*PO+ch*8,v);} }
  asm volatile("s_waitcnt lgkmcnt(0)\n\ts_barrier":::"memory");
  #undef TOFF
  #undef DMA_K
  #undef DMA_V
  #undef CMASK
  #undef START
  #undef RESC
  #undef ROT
}
constexpr int ATTN_LDS_BYTES=LDS_BYTES;
#undef SBAR
#undef WAIT_BAR
}
namespace cg = cooperative_groups;
#define LAS __attribute__((address_space(3)))
typedef unsigned short bf16_t;
typedef float f32x4 __attribute__((ext_vector_type(4)));
typedef unsigned v4u __attribute__((ext_vector_type(4)));
constexpr int NWAVES = 8, NTHREADS = 512;
constexpr int D = 1024, FF = 2816, MREAL = 16384, MVALID = 16416, MPAD = 16640, QKVW = 1536, QKV_ROWS = 16704;
constexpr int S5R = 1026;
constexpr float LN_EPS = 1e-5f, QK_EPS = 1e-6f;
constexpr float DN_ALPHA = 1.681792830507429f;
constexpr size_t MiB = 1u << 20;
constexpr size_t WS_WMIX = 1 * MiB, WS_WGU = 7 * MiB, WS_WDN = 18 * MiB, WS_TMAT = 24 * MiB, WS_BPOW = 40 * MiB, WS_A16 = 48 * MiB, WS_HMETA = 49 * MiB, WS_HB = 50 * MiB, WS_X = 83 * MiB;
constexpr size_t WS_AG = WS_X, WS_SLOC = WS_X + 65 * MiB, WS_G = WS_SLOC, WS_Z = WS_G + 33 * MiB;
constexpr size_t WS_QKV = WS_X, WS_O = WS_X + 49 * MiB;
constexpr size_t WS_FF = WS_X;
constexpr size_t WS_END = 256 * MiB;
static_assert(WS_Z + 33 * MiB <= WS_END && WS_O + 33 * MiB <= WS_END && WS_FF + (size_t)MPAD * FF * 2 <= WS_END, "ws map");
static_assert((size_t)(64 * S5R + 256) * 1024 <= 65 * MiB && (size_t)64 * S5R * 1024 <= 65 * MiB && (size_t)QKV_ROWS * QKVW * 2 <= 49 * MiB && (size_t)MPAD * D * 2 <= 33 * MiB, "ws map 2");
constexpr int LDS_BYTES = 147456, RING_BYTES = 131072;

struct Args {
    const float *x, *meta, *lam_re, *lam_im, *log_dt, *b_re, *b_im, *c_re, *c_im, *s5d, *w_glu, *w_sout, *w_qkv, *q_gain, *k_gain, *w_aout, *w_gate, *w_up, *w_down, *ln_g, *ln_b;
    float* out; unsigned char* ws; int ph_lo, ph_hi;
};

__device__ __forceinline__ unsigned f2bf(float f) { unsigned u = __builtin_bit_cast(unsigned, f); return (u + 0x7fffu + ((u >> 16) & 1u)) >> 16; }
__device__ __forceinline__ unsigned pk2(float lo, float hi) { return f2bf(lo) | (f2bf(hi) << 16); }
__device__ __forceinline__ unsigned long long pk4(f32x4 v) { return (unsigned long long)pk2(v.x, v.y) | ((unsigned long long)pk2(v.z, v.w) << 32); }
__device__ __forceinline__ float wave_sum(float v) {
#pragma unroll
    for (int o = 1; o < 64; o <<= 1) v += __shfl_xor(v, o);
    return v;
}
#define LDS_WAIT() asm volatile("s_waitcnt lgkmcnt(0)" ::: "memory")

__device__ __forceinline__ void transpose_item(const float* W, int K, int N, bf16_t* WT, int mode, LAS float* scr, int item, int lane) {
    const int nblk = N / 32, kb = item / nblk, nb = item % nblk, k0 = 64 * kb, n0 = 32 * nb;
    const int orow0 = (mode == 0) ? n0 : ((n0 >> 7) * 256 + (mode - 1) * 128 + (n0 & 127));
#pragma unroll 8
    for (int i = 0; i < 32; ++i) { const int kk = 2 * i + (lane >> 5); scr[kk * 33 + (lane & 31)] = W[(size_t)(k0 + kk) * N + n0 + (lane & 31)]; }
    LDS_WAIT(); asm volatile("" ::: "memory");
    const int c = lane & 7;
#pragma unroll
    for (int j = 0; j < 4; ++j) { const int n = (lane >> 3) + 8 * j; const LAS float* s = scr + (8 * c) * 33 + n;
        v4u o; o.x = pk2(s[0 * 33], s[1 * 33]); o.y = pk2(s[2 * 33], s[3 * 33]); o.z = pk2(s[4 * 33], s[5 * 33]); o.w = pk2(s[6 * 33], s[7 * 33]);
        *(v4u*)(WT + (size_t)(orow0 + n) * K + k0 + 8 * c) = o; }
    LDS_WAIT(); asm volatile("" ::: "memory");
}
__device__ __forceinline__ void convert_weights(const Args& a, int which, int j, LAS unsigned char* lds, int gw, int ngw, int wave, int lane) {
    LAS float* scr = (LAS float*)(lds + wave * 16384);
    unsigned char* ws = a.ws;
    if (which == 0) {
        constexpr int I = (D / 64) * (D / 32);
        for (int it = gw; it < 2 * I; it += ngw) {
            if (it < I) transpose_item(a.w_glu + (size_t)j * D * D, D, D, (bf16_t*)(ws + WS_WMIX), 0, scr, it, lane);
            else transpose_item(a.w_sout + (size_t)j * D * D, D, D, (bf16_t*)(ws + WS_WMIX + 2 * MiB), 0, scr, it - I, lane);
        }
    } else if (which == 1) {
        constexpr int I1 = (D / 64) * (QKVW / 32), I2 = (D / 64) * (D / 32);
        for (int it = gw; it < I1 + I2; it += ngw) {
            if (it < I1) transpose_item(a.w_qkv + (size_t)j * D * QKVW, D, QKVW, (bf16_t*)(ws + WS_WMIX), 0, scr, it, lane);
            else transpose_item(a.w_aout + (size_t)j * D * D, D, D, (bf16_t*)(ws + WS_WMIX + 3 * MiB), 0, scr, it - I1, lane);
        }
    } else {
        constexpr int I1 = (D / 64) * (FF / 32), I3 = (FF / 64) * (D / 32);
        for (int it = gw; it < 2 * I1 + I3; it += ngw) {
            if (it < I1) transpose_item(a.w_gate + (size_t)j * D * FF, D, FF, (bf16_t*)(ws + WS_WGU), 1, scr, it, lane);
            else if (it < 2 * I1) transpose_item(a.w_up + (size_t)j * D * FF, D, FF, (bf16_t*)(ws + WS_WGU), 2, scr, it - I1, lane);
            else transpose_item(a.w_down + (size_t)j * FF * D, FF, D, (bf16_t*)(ws + WS_WDN), 0, scr, it - 2 * I1, lane);
        }
    }
}
__device__ __forceinline__ void s5_tables(const Args& a, int j, int g, LAS float* L, int tid) {
    LAS float* apw = L;
    LAS float* Bb = L + 4352;
    LAS float* Cc = Bb + 4096;
    LAS float* Kt = Cc + 4096;
    bf16_t* Tmat = (bf16_t*)(a.ws + WS_TMAT) + (size_t)g * 256 * 512;
    bf16_t* Bpow = (bf16_t*)(a.ws + WS_BPOW) + (size_t)g * 256 * 256;
    float* A16 = (float*)(a.ws + WS_A16);
    if (tid < 128) {
        const int dir = tid >> 6, p = tid & 63; const size_t gi = ((size_t)(j * 2 + dir) * 64 + g);
        const float lr = a.lam_re[gi * 64 + p], li = a.lam_im[gi * 64 + p], dt = expf(a.log_dt[gi]);
        const float mag = expf(lr * dt), abr = mag * cosf(li * dt), abi = mag * sinf(li * dt);
        const float nr = abr - 1.0f, ni = abi, den = lr * lr + li * li, cr = (nr * lr + ni * li) / den, ci = (ni * lr - nr * li) / den;
        float pr = 1.f, pi = 0.f;
        for (int k = 0; k <= 16; ++k) { apw[((dir * 17 + k) * 64 + p) * 2] = pr; apw[((dir * 17 + k) * 64 + p) * 2 + 1] = pi; const float t = pr * abr - pi * abi; pi = pr * abi + pi * abr; pr = t; }
        A16[((g * 2 + dir) * 64 + p) * 2] = apw[((dir * 17 + 16) * 64 + p) * 2]; A16[((g * 2 + dir) * 64 + p) * 2 + 1] = apw[((dir * 17 + 16) * 64 + p) * 2 + 1];
        for (int c = 0; c < 16; ++c) { const float br = a.b_re[(gi * 64 + p) * 16 + c], bi = a.b_im[(gi * 64 + p) * 16 + c];
            Bb[((dir * 64 + p) * 16 + c) * 2] = cr * br - ci * bi; Bb[((dir * 64 + p) * 16 + c) * 2 + 1] = cr * bi + ci * br; }
    }
    for (int q = 0; q < 4; ++q) { const int idx = tid + 512 * q, dir = idx >> 10, co = (idx >> 6) & 15, p = idx & 63; const size_t ci_ = (((size_t)(j * 2 + dir) * 64 + g) * 16 + co) * 64 + p;
        Cc[idx * 2] = a.c_re[ci_]; Cc[idx * 2 + 1] = a.c_im[ci_]; }
    __syncthreads();
    for (int q = 0; q < 16; ++q) { const int o = tid + 512 * q, dir = o >> 12, k = (o >> 8) & 15, co = (o >> 4) & 15, ci = o & 15; float s = 0.f;
        for (int p = 0; p < 64; ++p) { const float ar = apw[((dir * 17 + k) * 64 + p) * 2], ai = apw[((dir * 17 + k) * 64 + p) * 2 + 1], br = Bb[((dir * 64 + p) * 16 + ci) * 2], bi = Bb[((dir * 64 + p) * 16 + ci) * 2 + 1];
            const float wr = ar * br - ai * bi, wi = ar * bi + ai * br; s += Cc[((dir * 16 + co) * 64 + p) * 2] * wr - Cc[((dir * 16 + co) * 64 + p) * 2 + 1] * wi; }
        Kt[o] = s; }
    __syncthreads();
    { const int n = tid >> 1, half = tid & 1, t = n >> 4, co = n & 15; bf16_t* rowp = Tmat + (size_t)n * 512 + half * 256;
        if (half == 0) {
            for (int s = 0; s < 16; ++s) { float v[16];
#pragma unroll
                for (int ci = 0; ci < 16; ++ci) { float x = 0.f; if (s <= t) x += Kt[((0 * 16 + (t - s)) * 16 + co) * 16 + ci]; if (s >= t) x += Kt[((1 * 16 + (s - t)) * 16 + co) * 16 + ci]; v[ci] = x; }
                v4u o0, o1; o0.x = pk2(v[0], v[1]); o0.y = pk2(v[2], v[3]); o0.z = pk2(v[4], v[5]); o0.w = pk2(v[6], v[7]); o1.x = pk2(v[8], v[9]); o1.y = pk2(v[10], v[11]); o1.z = pk2(v[12], v[13]); o1.w = pk2(v[14], v[15]);
                *(v4u*)(rowp + s * 16) = o0; *(v4u*)(rowp + s * 16 + 8) = o1; }
        } else {
            for (int q = 0; q < 32; ++q) { float v[8];
                const int dir = q >> 4, ri = (q >> 3) & 1, ex = dir == 0 ? t + 1 : 16 - t;
#pragma unroll
                for (int e = 0; e < 8; ++e) { const int p = 8 * (q & 7) + e; const float cr = Cc[((dir * 16 + co) * 64 + p) * 2], ci = Cc[((dir * 16 + co) * 64 + p) * 2 + 1], ar = apw[((dir * 17 + ex) * 64 + p) * 2], ai = apw[((dir * 17 + ex) * 64 + p) * 2 + 1];
                    v[e] = ri == 0 ? (cr * ar - ci * ai) : -(cr * ai + ci * ar); }
                v4u o0; o0.x = pk2(v[0], v[1]); o0.y = pk2(v[2], v[3]); o0.z = pk2(v[4], v[5]); o0.w = pk2(v[6], v[7]); *(v4u*)(rowp + q * 8) = o0; }
        }
    }
    { const int n = tid >> 1, half = tid & 1, dir = n >> 7, ri = (n >> 6) & 1, p = n & 63; bf16_t* rowp = Bpow + (size_t)n * 256 + half * 128;
        for (int s8 = 0; s8 < 8; ++s8) { const int s = 8 * half + s8, ex = dir == 0 ? 15 - s : s; const float ar = apw[((dir * 17 + ex) * 64 + p) * 2], ai = apw[((dir * 17 + ex) * 64 + p) * 2 + 1]; float v[16];
#pragma unroll
            for (int ci = 0; ci < 16; ++ci) { const float br = Bb[((dir * 64 + p) * 16 + ci) * 2], bi = Bb[((dir * 64 + p) * 16 + ci) * 2 + 1]; v[ci] = ri == 0 ? (ar * br - ai * bi) : (ar * bi + ai * br); }
            v4u o0, o1; o0.x = pk2(v[0], v[1]); o0.y = pk2(v[2], v[3]); o0.z = pk2(v[4], v[5]); o0.w = pk2(v[6], v[7]); o1.x = pk2(v[8], v[9]); o1.y = pk2(v[10], v[11]); o1.z = pk2(v[12], v[13]); o1.w = pk2(v[14], v[15]);
            *(v4u*)(rowp + s8 * 16) = o0; *(v4u*)(rowp + s8 * 16 + 8) = o1; }
    }
    __syncthreads();
}
__device__ __forceinline__ float* hrow(const Args& a, int m) { return m < MREAL ? a.out + (size_t)m * D : (float*)(a.ws + WS_HMETA) + (size_t)(m - MREAL) * D; }
__device__ __forceinline__ void write_row(const Args& a, int m, const f32x4 (&v)[4], bf16_t* ag, int lane) {
    f32x4* ho = (f32x4*)hrow(a, m) + lane;
    unsigned long long* o8 = (unsigned long long*)((bf16_t*)(a.ws + WS_HB) + (size_t)m * D) + lane;
#pragma unroll
    for (int j = 0; j < 4; ++j) { ho[64 * j] = v[j]; o8[64 * j] = pk4(v[j]); }
    if (ag && m < MVALID) {
#pragma unroll
        for (int j = 0; j < 4; ++j) { const int g = (lane >> 2) + 16 * j; *(unsigned long long*)(ag + ((size_t)g * S5R + (m >> 4)) * 512 + (m & 15) * 16 + 4 * (lane & 3)) = pk4(v[j]); }
    }
}
__device__ __forceinline__ void init_rows(const Args& a, int gw, int ngw, int lane) {
    bf16_t* ag = (bf16_t*)(a.ws + WS_AG);
    for (int m = gw; m < MPAD; m += ngw) { f32x4 v[4];
        const float* src = m < MREAL ? a.x + (size_t)m * D : a.meta + (size_t)((m - MREAL) & 15) * D;
#pragma unroll
        for (int j = 0; j < 4; ++j) v[j] = m < MVALID ? ((const f32x4*)src)[lane + 64 * j] : (f32x4){0.f, 0.f, 0.f, 0.f};
        write_row(a, m, v, ag, lane); }
}
__device__ __forceinline__ void ln_phase(const Args& a, int lnidx, bool want_ag, int gw, int ngw, int lane) {
    bf16_t* ag = want_ag ? (bf16_t*)(a.ws + WS_AG) : nullptr;
    f32x4 gn[4], bs[4];
#pragma unroll
    for (int j = 0; j < 4; ++j) { gn[j] = ((const f32x4*)(a.ln_g + (size_t)lnidx * D))[lane + 64 * j]; bs[j] = ((const f32x4*)(a.ln_b + (size_t)lnidx * D))[lane + 64 * j]; }
    for (int m = gw; m < MPAD; m += ngw) { f32x4 v[4];
        if (m < MVALID) { const f32x4* xr = (const f32x4*)hrow(a, m) + lane; float s = 0.f;
#pragma unroll
            for (int j = 0; j < 4; ++j) { v[j] = xr[64 * j]; s += (v[j].x + v[j].y) + (v[j].z + v[j].w); }
            const float mean = wave_sum(s) * (1.f / D); float s2 = 0.f;
#pragma unroll
            for (int j = 0; j < 4; ++j) { v[j] = v[j] - mean; s2 += (v[j].x * v[j].x + v[j].y * v[j].y) + (v[j].z * v[j].z + v[j].w * v[j].w); }
            const float rstd = 1.f / sqrtf(wave_sum(s2) * (1.f / D) + LN_EPS);
#pragma unroll
            for (int j = 0; j < 4; ++j) v[j] = v[j] * rstd * gn[j] + bs[j];
        } else {
#pragma unroll
            for (int j = 0; j < 4; ++j) v[j] = (f32x4){0.f, 0.f, 0.f, 0.f};
        }
        write_row(a, m, v, ag, lane); }
}
__device__ __forceinline__ void s5_scan(const Args& a, int task, int lane) {
    const int g = task >> 2, b = (task >> 1) & 1, dir = task & 1;
    const float* A16 = (const float*)(a.ws + WS_A16); const float ar = A16[((g * 2 + dir) * 64 + lane) * 2], ai = A16[((g * 2 + dir) * 64 + lane) * 2 + 1];
    const float* Sl = (const float*)(a.ws + WS_SLOC) + (size_t)g * S5R * 256 + dir * 128 + lane;
    bf16_t* Ag = (bf16_t*)(a.ws + WS_AG) + (size_t)g * S5R * 512 + 256 + dir * 128 + lane;
    float sr = 0.f, si = 0.f;
#define S5ROW(c) ((c) == 0 ? 1024 + b : 512 * b + (c) - 1)
    for (int base = 0; base < 512; base += 32) { float lr[32], li[32];
#pragma unroll
        for (int q = 0; q < 32; ++q) { const int c = dir == 0 ? base + q : 512 - (base + q); const int r = S5ROW(c); lr[q] = Sl[(size_t)r * 256]; li[q] = Sl[(size_t)r * 256 + 64]; }
#pragma unroll
        for (int q = 0; q < 32; ++q) { const int c = dir == 0 ? base + q : 512 - (base + q); const int r = S5ROW(c);
            Ag[(size_t)r * 512] = (bf16_t)f2bf(sr); Ag[(size_t)r * 512 + 64] = (bf16_t)f2bf(si);
            const float t = ar * sr - ai * si + lr[q]; si = ar * si + ai * sr + li[q]; sr = t; }
    }
    { const int c = dir == 0 ? 512 : 0; const int r = S5ROW(c); Ag[(size_t)r * 512] = (bf16_t)f2bf(sr); Ag[(size_t)r * 512 + 64] = (bf16_t)f2bf(si); }
#undef S5ROW
}
__device__ __forceinline__ void normrope_phase(const Args& a, int j, int gw, int ngw, int lane) {
    bf16_t* QKV = (bf16_t*)(a.ws + WS_QKV);
    const float qg = a.q_gain[j * 64 + lane] * attn_body::C2, kg = a.k_gain[j * 64 + lane];
    const int i = lane & 15, axis = lane >> 5; const float invf = exp2f(-(float)i * 0.8304820237218406f);
    const bool second = (lane >> 4) & 1;
    for (int m = gw; m < MVALID; m += ngw) {
        const int t = m & 8191; const float pos = m < MREAL ? (float)(axis ? (t & 63) : (t >> 6)) : 0.f;
        const float ang = pos * invf, cs = cosf(ang), sn = sinf(ang);
        bf16_t* row = QKV + (size_t)m * QKVW + lane; float x[20];
#pragma unroll
        for (int h = 0; h < 20; ++h) x[h] = __uint_as_float((unsigned)row[h * 64] << 16);
#pragma unroll
        for (int h = 0; h < 20; ++h) { const float ss = wave_sum(x[h] * x[h]); const float y = x[h] * (1.f / sqrtf(ss * (1.f / 64.f) + QK_EPS)) * (h < 16 ? qg : kg);
            const float o = __shfl_xor(y, 16); const float r = second ? (y * cs + o * sn) : (y * cs - o * sn); row[h * 64] = (bf16_t)f2bf(r); }
    }
}
#define XB_TMO      128
#define XB_XCNT(j)  (256  + 64 * (j))
#define XB_XSUB(j)  (1280 + 64 * (j))
#define XB_XGEN(j)  (2304 + 64 * (j))
#define XB_TOP      3328
#define XB_TOPGEN   3392
#define XCD_BAR_WORDS 3456
#define XB_SPIN_CAP (1u << 18)

__device__ __forceinline__ unsigned xb_ld(unsigned* p)              { return __hip_atomic_load(p, __ATOMIC_RELAXED, __HIP_MEMORY_SCOPE_AGENT); }
__device__ __forceinline__ unsigned xb_add(unsigned* p, unsigned v) { return __hip_atomic_fetch_add(p, v, __ATOMIC_RELAXED, __HIP_MEMORY_SCOPE_AGENT); }
__device__ __forceinline__ unsigned xb_xcc_id() { return (unsigned)__builtin_amdgcn_s_getreg((3 << 11) | 20) & 0xFu; }
#define XB_SPIN(cond, bar) do { unsigned _sp = 0; while (cond) { __builtin_amdgcn_s_sleep(1); \
    if ((++_sp & 255u) == 0u) { if (xb_ld(&(bar)[XB_TMO])) break; if (_sp > XB_SPIN_CAP) { atomicAdd(&(bar)[XB_TMO], 1u); break; } } } } while (0)

struct XcdBarrier {
    unsigned* bar; unsigned x;
    volatile LAS unsigned* st;
};

__device__ __forceinline__ XcdBarrier xcd_barrier_post(unsigned* bar, volatile LAS unsigned* st) {
    XcdBarrier b; b.bar = bar; b.x = xb_xcc_id(); b.st = st;
    if (threadIdx.x == 0) (void)xb_add(&bar[XB_XCNT(b.x)], 1u);
    return b;
}
__device__ __forceinline__ void xcd_barrier_complete(unsigned* bar, unsigned x, unsigned& nloc, unsigned& nx) {
    const unsigned G = gridDim.x * gridDim.y * gridDim.z;
    unsigned sum, cnt, mine, sp = 0u;
    for (;;) {
        sum = 0u; cnt = 0u; mine = 0u;
#pragma unroll
        for (unsigned j = 0; j < 16; ++j) { const unsigned c = xb_ld(&bar[XB_XCNT(j)]); sum += c; cnt += (c > 0u) ? 1u : 0u; mine = (j == x) ? c : mine; }
        if (sum == G) break;
        __builtin_amdgcn_s_sleep(1);
        if ((++sp & 255u) == 0u) { if (xb_ld(&bar[XB_TMO])) break; if (sp > XB_SPIN_CAP) { atomicAdd(&bar[XB_TMO], 1u); break; } }
    }
    nloc = mine > 0u ? mine : 1u; nx = cnt > 0u ? cnt : 1u;
}

__device__ __forceinline__ void xcd_barrier(const XcdBarrier& b) {
    asm volatile("s_waitcnt vmcnt(0)" ::: "memory");
    __syncthreads();
    if (threadIdx.x == 0) {
        unsigned* bar = b.bar;
        __builtin_amdgcn_s_waitcnt(0);
        unsigned nloc = b.st[0], nx = b.st[1];
        if (nloc == 0u) { xcd_barrier_complete(bar, b.x, nloc, nx); b.st[0] = nloc; b.st[1] = nx; }
        const unsigned old = xb_add(&bar[XB_XSUB(b.x)], 1u);
        const unsigned gen = old / nloc;
        if (old + 1u == (gen + 1u) * nloc) {
            __builtin_amdgcn_fence(__ATOMIC_RELEASE, "agent");
            asm volatile("s_waitcnt vmcnt(0)" ::: "memory");
            const unsigned og = xb_add(&bar[XB_TOP], 1u);
            const unsigned tg = og / nx;
            if (og + 1u == (tg + 1u) * nx) xb_add(&bar[XB_TOPGEN], 1u);
            else XB_SPIN(xb_ld(&bar[XB_TOPGEN]) == tg, bar);
            __builtin_amdgcn_fence(__ATOMIC_ACQUIRE, "agent");
            xb_add(&bar[XB_XGEN(b.x)], 1u);
            asm volatile("s_waitcnt vmcnt(0)" ::: "memory");
        } else {
            XB_SPIN(xb_ld(&bar[XB_XGEN(b.x)]) == gen, bar);
            __builtin_amdgcn_fence(__ATOMIC_ACQUIRE, "agent");
            asm volatile("s_waitcnt vmcnt(0)" ::: "memory");
        }
    }
    __syncthreads();
}
constexpr int NPH = 35;
enum { K_P0, K_S5A, K_S5B, K_S5C, K_GLU, K_RESMIX, K_LN1, K_GU, K_RESDN, K_LN2, K_QKV, K_ROPE, K_ATTN };
template <int KIND, int LAYER>
__device__ __forceinline__ void run_phase(const Args& a, unsigned char* lds, int G, int bx, int vcu) {
    int tid_ = threadIdx.x; asm volatile("" : "+v"(tid_));
    const int tid = tid_, lane = tid & 63, wave = __builtin_amdgcn_readfirstlane(tid >> 6);
    const int gw = vcu * NWAVES + wave, ngw = G * NWAVES;
    LAS unsigned char* L = (LAS unsigned char*)lds;
    unsigned char* ws = a.ws;
    float* hmeta = (float*)(ws + WS_HMETA);
    constexpr int layer = LAYER, j = LAYER >> 1; constexpr bool is_attn = LAYER & 1;
    if constexpr (KIND == K_P0) {
        convert_weights(a, 0, 0, L, gw, ngw, wave, lane);
        convert_weights(a, 2, 0, L, gw, ngw, wave, lane);
        __syncthreads();
        for (int g = bx; g < 64; g += G) s5_tables(a, 0, g, (LAS float*)L, tid);
        init_rows(a, gw, ngw, lane);
    } else if constexpr (KIND == K_S5A) {
        pg8::Gemm g{(const bf16_t*)(ws + WS_AG), (const bf16_t*)(ws + WS_BPOW), 0, 256, 256, 512};
        pg8::S5Order S{G, bx, 1024, 512}; pg8::EpiS5a E{(float*)(ws + WS_SLOC)};
        pg8::gemm_phase<pg8::EpiS5a, pg8::S5Order, true, true>(L, g, S, E);
        if constexpr (layer > 0) convert_weights(a, 2, layer, L, gw, ngw, wave, lane);
    } else if constexpr (KIND == K_S5B) {
        if (wave == 0) for (int task = bx; task < 256; task += G) s5_scan(a, task, lane);
    } else if constexpr (KIND == K_S5C) {
        pg8::Gemm g{(const bf16_t*)(ws + WS_AG), (const bf16_t*)(ws + WS_TMAT), 0, 256, 512, 512};
        pg8::S5Order S{G, bx, 1024, 1024}; pg8::EpiS5c E{a.out, hmeta, a.s5d + (size_t)j * D, (bf16_t*)(ws + WS_G)};
        pg8::gemm_phase<pg8::EpiS5c, pg8::S5Order, true, true>(L, g, S, E);
    } else if constexpr (KIND == K_GLU) {
        pg8::Gemm g{(const bf16_t*)(ws + WS_G), (const bf16_t*)(ws + WS_WMIX), MPAD, D, D, D}; pg8::StaticOrder S; S.init(MPAD, D, D, D, G, bx);
        pg8::EpiGlu E{(const bf16_t*)(ws + WS_G), (bf16_t*)(ws + WS_Z)};
        pg8::gemm_phase<pg8::EpiGlu, pg8::StaticOrder, true, true>(L, g, S, E);
    } else if constexpr (KIND == K_RESMIX || KIND == K_RESDN) {
        constexpr bool dn = KIND == K_RESDN; constexpr int K = dn ? FF : D;
        const bf16_t* A = dn ? (const bf16_t*)(ws + WS_FF) : is_attn ? (const bf16_t*)(ws + WS_O) : (const bf16_t*)(ws + WS_Z);
        const bf16_t* Bt = dn ? (const bf16_t*)(ws + WS_WDN) : is_attn ? (const bf16_t*)(ws + WS_WMIX + 3 * MiB) : (const bf16_t*)(ws + WS_WMIX + 2 * MiB);
        pg8::Gemm g{A, Bt, MPAD, D, K, K}; pg8::StaticOrder S; S.init(MPAD, D, K, K, G, bx);
        pg8::EpiRes E{a.out, hmeta, DN_ALPHA};
        pg8::gemm_phase<pg8::EpiRes, pg8::StaticOrder, true, true>(L, g, S, E);
    } else if constexpr (KIND == K_LN1 || KIND == K_LN2) {
        constexpr bool second = KIND == K_LN2;
        ln_phase(a, layer * 2 + (second ? 1 : 0), second && layer < 3 && !((layer + 1) & 1), gw, ngw, lane);
    } else if constexpr (KIND == K_GU) {
        pg8::Gemm g{(const bf16_t*)(ws + WS_HB), (const bf16_t*)(ws + WS_WGU), MPAD, 2 * FF, D, D}; pg8::StaticOrder S; S.init(MPAD, 2 * FF, D, D, G, bx);
        pg8::EpiSwiGlu E{(bf16_t*)(ws + WS_FF), FF};
        pg8::gemm_phase<pg8::EpiSwiGlu, pg8::StaticOrder, true, true>(L, g, S, E);
        if constexpr (layer < 3) {
            convert_weights(a, (layer + 1) & 1, (layer + 1) >> 1, L, gw, ngw, wave, lane);
            if constexpr (!((layer + 1) & 1)) { __syncthreads(); for (int g2 = bx; g2 < 64; g2 += G) s5_tables(a, (layer + 1) >> 1, g2, (LAS float*)L, tid); }
        }
    } else if constexpr (KIND == K_QKV) {
        pg8::Gemm g{(const bf16_t*)(ws + WS_HB), (const bf16_t*)(ws + WS_WMIX), MPAD, QKVW, D, D}; pg8::StaticOrder S; S.init(MPAD, QKVW, D, D, G, bx);
        pg8::EpiBf16<0> E{(bf16_t*)(ws + WS_QKV), QKVW, nullptr, 0, 0, 1.f};
        pg8::gemm_phase<pg8::EpiBf16<0>, pg8::StaticOrder, true, true>(L, g, S, E);
        convert_weights(a, 2, layer, L, gw, ngw, wave, lane);
    } else if constexpr (KIND == K_ROPE) {
        normrope_phase(a, j, gw, ngw, lane);
    } else if constexpr (KIND == K_ATTN) {
        const attn_body::bf16* QKV = (const attn_body::bf16*)(ws + WS_QKV); attn_body::bf16* O = (attn_body::bf16*)(ws + WS_O);
        if (G == 256) {
#pragma unroll 1
            for (int i = 0; i < 5; ++i) {
                int b, h, nvalid; long rows0;
                if (i < 4) { const int bh = vcu >> 3; b = bh >> 4; h = bh & 15; rows0 = (long)b * 8192 + ((vcu & 7) * 4 + i) * 256; nvalid = 256; }
                else { if (vcu >= 32 || LAYER == 3) break;     b = vcu >> 4; h = vcu & 15; rows0 = MREAL + 16 * b; nvalid = 16; }
                const attn_body::bf16* Kh = QKV + (long)b * 8192 * attn_body::PQ + 1024 + (h >> 2) * 64;
                attn_body::attn_unit<8>(QKV + rows0 * attn_body::PQ + h * 64, Kh, Kh + 256, (long)(MREAL + 16 * b - 8192 * b), O + rows0 * attn_body::PO + h * 64, nvalid, (char*)lds);
            }
        }
    }
}
__global__ void __launch_bounds__(NTHREADS, 2) mk_fwd(Args a) {
    extern __shared__ __attribute__((aligned(16))) unsigned char lds[];
    cg::grid_group grid = cg::this_grid();
    const int G = gridDim.x, bx = blockIdx.x, vcu = (G % 8 == 0) ? (bx % 8) * (G / 8) + bx / 8 : bx;
    const int lo = a.ph_lo, hi = a.ph_hi;
    volatile LAS unsigned* bst = (volatile LAS unsigned*)((LAS unsigned char*)lds + 139264);
    if (threadIdx.x < 2) bst[threadIdx.x] = 0u;
    __syncthreads();
    const XcdBarrier bar = xcd_barrier_post((unsigned*)a.ws + 4096, bst);
#define PH(k, KIND, LAYER) if (lo <= (k) && (k) < hi) { run_phase<KIND, LAYER>(a, lds, G, bx, vcu); if ((k) + 1 < hi) { if ((k) == 0) grid.sync(); else xcd_barrier(bar); } }
#define S5LAYER(k0, LY) PH(k0, K_S5A, LY) PH(k0 + 1, K_S5B, LY) PH(k0 + 2, K_S5C, LY) PH(k0 + 3, K_GLU, LY) PH(k0 + 4, K_RESMIX, LY) PH(k0 + 5, K_LN1, LY) PH(k0 + 6, K_GU, LY) PH(k0 + 7, K_RESDN, LY) PH(k0 + 8, K_LN2, LY)
#define ATLAYER(k0, LY) PH(k0, K_QKV, LY) PH(k0 + 1, K_ROPE, LY) PH(k0 + 2, K_ATTN, LY) PH(k0 + 3, K_RESMIX, LY) PH(k0 + 4, K_LN1, LY) PH(k0 + 5, K_GU, LY) PH(k0 + 6, K_RESDN, LY) PH(k0 + 7, K_LN2, LY)
    PH(0, K_P0, 0)
    S5LAYER(1, 0)
    ATLAYER(10, 1)
    S5LAYER(18, 2)
    ATLAYER(27, 3)
#undef PH
}

extern "C" void kernel_launch(void* const* d_in, const int* in_sizes, int n_in, void* d_out, int out_size, void* d_ws, size_t ws_size, hipStream_t stream) {
    static int grid = 0;
    if (grid == 0) {
        int dev = 0, cus = 0, per_cu = 0;
        if (n_in != 21 || out_size != MREAL * D || ws_size < WS_END) { fprintf(stderr, "kernel_launch: unexpected shapes (n_in %d out %d ws %zu)\n", n_in, out_size, ws_size); grid = -1; return; }
        hipGetDevice(&dev); hipDeviceGetAttribute(&cus, hipDeviceAttributeMultiprocessorCount, dev);
        hipFuncSetAttribute((const void*)mk_fwd, hipFuncAttributeMaxDynamicSharedMemorySize, LDS_BYTES);
        hipOccupancyMaxActiveBlocksPerMultiprocessor(&per_cu, (const void*)mk_fwd, NTHREADS, LDS_BYTES);
        (void)hipGetLastError();
        grid = cus * (per_cu >= 1 ? 1 : 1);
        if (grid != 256) fprintf(stderr, "kernel_launch: grid %d (expected 256)\n", grid);
    }
    if (grid < 0) return;
    if (hipMemsetAsync(d_ws, 0, 65536, stream) != hipSuccess) { fprintf(stderr, "kernel_launch: memset failed\n"); return; }
    Args a{};
    const float** p = (const float**)&a;
    for (int i = 0; i < 21; ++i) p[i] = (const float*)d_in[i];
    a.out = (float*)d_out; a.ws = (unsigned char*)d_ws; a.ph_lo = 0; a.ph_hi = NPH;
    void* args[] = {&a};
    hipError_t e = hipLaunchCooperativeKernel((const void*)mk_fwd, dim3(grid), dim3(NTHREADS), args, LDS_BYTES, stream);
    if (e != hipSuccess) fprintf(stderr, "cooperative launch failed: %s (grid %d)\n", hipGetErrorString(e), grid);
}
```

```cpp
#include <hip/hip_runtime.h>
#include <hip/hip_cooperative_groups.h>
#include <cstdio>
#include <cstdint>
namespace pg8 {
#define PG8_LAS __attribute__((address_space(3)))
typedef unsigned short bf16_t;
typedef short bf16x8 __attribute__((ext_vector_type(8)));
typedef float f32x4 __attribute__((ext_vector_type(4)));
typedef unsigned u32x4 __attribute__((ext_vector_type(4)));
constexpr int BM = 256, BK = 64, HALF = 128, HTB = HALF * BK * 2  , STAGE_BYTES = 8 * HTB, NXCD = 8, WGM = 8;

__host__ __device__ __forceinline__ int lds_byte(int r, int c) { const int st = (r >> 4) * 2 + (c >> 5), rr = r & 15, cc = c & 31, ob = rr * 64 + cc * 2; return st * 1024 + (ob ^ (((ob >> 9) & 1) << 5)); }
__host__ __device__ __forceinline__ void stage_rc(int b, int& R, int& C) { const int st = b / 1024, sb = b % 1024, swz = sb ^ (((sb >> 9) & 1) << 5); R = (st >> 1) * 16 + swz / 64; C = (st & 1) * 32 + (swz % 64) / 2; }
__host__ __device__ __forceinline__ int perm32(int rho) { const int n = rho >> 4, i = rho & 15; return 8 * (i >> 2) + 4 * n + (i & 3); }

struct Unit { int pm, pn; long aoff, boff; };
struct Gemm { const bf16_t* A; const bf16_t* Bt; int M, N, K, lda; };

struct StaticOrder {
    int nM, nN, nwg, G, c; long astep, bstep;
    __host__ __device__ void init(int M, int N, int K, int lda, int G_, int c_) { nM = M / BM; nN = N / BM; nwg = nM * nN; G = G_; c = c_; astep = (long)BM * lda * 2; bstep = (long)BM * K * 2; }
    __host__ __device__ bool next(int i, Unit& u) const {
        const long L = (long)i * G + c; if (L >= nwg) return false;
        int wgid = (int)L; { const int q = nwg / NXCD, r = nwg % NXCD, xcd = wgid % NXCD, off = wgid / NXCD; wgid = (xcd < r ? xcd * (q + 1) : r * (q + 1) + (xcd - r) * q) + off; }
        const int nig = WGM * nN, gid = wgid / nig, fm = gid * WGM, gsz = (nM - fm) < WGM ? (nM - fm) : WGM;
        u.pm = fm + ((wgid % nig) % gsz); u.pn = (wgid % nig) / gsz; u.aoff = u.pm * astep; u.boff = u.pn * bstep; return true;
    }
    __device__ __forceinline__ void a_ready(const Unit&) const {}
    __device__ __forceinline__ void done(const Unit&) const {}
};

__device__ __forceinline__ unsigned cvt_pk_bf16(float lo, float hi) { unsigned r; asm volatile("v_cvt_pk_bf16_f32 %0, %1, %2" : "=v"(r) : "v"(lo), "v"(hi)); return r; }
typedef float f32x2 __attribute__((ext_vector_type(2)));
__device__ __forceinline__ f32x2 gelu_pk(f32x2 v) {
    const f32x2 av = __builtin_elementwise_abs(v), d = av * 0.2316418882f + 1.0f;
    f32x2 t; t.x = __builtin_amdgcn_rcpf(d.x); t.y = __builtin_amdgcn_rcpf(d.y);
    f32x2 q = t * 0.5307027145f + (-0.7265760135f); q = q * t + 0.7107068705f; q = q * t + (-0.142248368f); q = q * t + 0.127414796f; q = q * t;
    const f32x2 s = (v * v) * (-0.72134752044f);
    f32x2 e; e.x = __builtin_amdgcn_exp2f(s.x); e.y = __builtin_amdgcn_exp2f(s.y);
    const f32x2 m = v * (q * e), r = v - m;
    f32x2 o; o.x = v.x < 0.f ? m.x : r.x; o.y = v.y < 0.f ? m.y : r.y; return o;
}

template <int ACT  > struct EpiBf16 {
    static constexpr bool PERM = true, AFTER_DRAIN = false; static_assert(ACT == 0 || ACT == 1, "EpiBf16: ACT is 0 (none) or 1 (gelu_pk)");
    bf16_t* O; int ldc; const float* bias; int split_cols; size_t split_stride; float scale0;
    __device__ __forceinline__ void operator()(const f32x4 (&acc)[2][2][4][2], const Unit& u, int wr, int wc, int fr, int fq) const {
        const int row0 = u.pm * BM + wr * 64 + fr; int colt = u.pn * BM; bf16_t* base = O;
        float sc = 1.f; if (split_cols) { const int t = colt / split_cols; base += (size_t)t * split_stride; colt -= t * split_cols; if (t == 0) sc = scale0; }
        const int col0 = colt + wc * 32 + 8 * fq, bcol0 = u.pn * BM + wc * 32 + 8 * fq;
        f32x4 bv[2][2];
#pragma unroll
        for (int bj = 0; bj < 2; ++bj)
#pragma unroll
            for (int n = 0; n < 2; ++n) bv[bj][n] = bias ? *(const f32x4*)(bias + bcol0 + bj * HALF + 4 * n) : (f32x4){0.f, 0.f, 0.f, 0.f};
#pragma unroll
        for (int ai = 0; ai < 2; ++ai)
#pragma unroll
            for (int m = 0; m < 4; ++m) { bf16_t* rowp = base + (size_t)(row0 + ai * HALF + m * 16) * ldc + col0;
#pragma unroll
                for (int bj = 0; bj < 2; ++bj) { f32x4 v0 = acc[ai][bj][m][0] + bv[bj][0], v1 = acc[ai][bj][m][1] + bv[bj][1];
                    if (ACT == 1) { f32x2 a = gelu_pk((f32x2){v0[0], v0[1]}), b = gelu_pk((f32x2){v0[2], v0[3]}), c = gelu_pk((f32x2){v1[0], v1[1]}), d = gelu_pk((f32x2){v1[2], v1[3]});
                        v0 = (f32x4){a.x, a.y, b.x, b.y}; v1 = (f32x4){c.x, c.y, d.x, d.y}; }
                    v0 = v0 * sc; v1 = v1 * sc; u32x4 w; w.x = cvt_pk_bf16(v0[0], v0[1]); w.y = cvt_pk_bf16(v0[2], v0[3]); w.z = cvt_pk_bf16(v1[0], v1[1]); w.w = cvt_pk_bf16(v1[2], v1[3]);
                    *(u32x4*)(rowp + bj * HALF) = w; } }
    }
};
constexpr int MREAL = 16384;
typedef unsigned u32x2e __attribute__((ext_vector_type(2)));
__device__ __forceinline__ float bf_lo(unsigned w) { return __uint_as_float(w << 16); }
__device__ __forceinline__ float bf_hi(unsigned w) { return __uint_as_float(w & 0xffff0000u); }
__device__ __forceinline__ float sigmoid_f(float x) { return __builtin_amdgcn_rcpf(1.f + __builtin_amdgcn_exp2f(-1.4426950408889634f * x)); }
struct EpiRes {
    static constexpr bool PERM = false, AFTER_DRAIN = false;
    float* hreal; float* hmeta; float alpha;
    __device__ __forceinline__ void operator()(const f32x4 (&acc)[2][2][4][2], const Unit& u, int wr, int wc, int fr, int fq) const {
        float* base = (u.pm < MREAL / BM) ? hreal + (size_t)u.pm * BM * 1024 : hmeta + (size_t)(u.pm - MREAL / BM) * BM * 1024;
        const int col0 = u.pn * BM + wc * 32 + 4 * fq;
#pragma unroll
        for (int ai = 0; ai < 2; ++ai)
#pragma unroll
            for (int m = 0; m < 4; ++m) { float* rowp = base + (size_t)(ai * HALF + wr * 64 + m * 16 + fr) * 1024 + col0;
#pragma unroll
                for (int bj = 0; bj < 2; ++bj)
#pragma unroll
                    for (int n = 0; n < 2; ++n) { f32x4* p = (f32x4*)(rowp + bj * HALF + n * 16); const f32x4 hv = *p; *p = hv * alpha + acc[ai][bj][m][n]; } }
    }
};
struct EpiGlu {
    static constexpr bool PERM = true, AFTER_DRAIN = false;
    const bf16_t* Gb; bf16_t* Z;
    __device__ __forceinline__ void operator()(const f32x4 (&acc)[2][2][4][2], const Unit& u, int wr, int wc, int fr, int fq) const {
        const int row0 = u.pm * BM + wr * 64 + fr, col0 = u.pn * BM + wc * 32 + 8 * fq;
#pragma unroll
        for (int ai = 0; ai < 2; ++ai)
#pragma unroll
            for (int m = 0; m < 4; ++m) { const size_t off = (size_t)(row0 + ai * HALF + m * 16) * 1024 + col0;
#pragma unroll
                for (int bj = 0; bj < 2; ++bj) { const u32x4 gv = *(const u32x4*)(Gb + off + bj * HALF); const f32x4 a0 = acc[ai][bj][m][0], a1 = acc[ai][bj][m][1]; u32x4 w;
                    w.x = cvt_pk_bf16(bf_lo(gv.x) * sigmoid_f(a0[0]), bf_hi(gv.x) * sigmoid_f(a0[1])); w.y = cvt_pk_bf16(bf_lo(gv.y) * sigmoid_f(a0[2]), bf_hi(gv.y) * sigmoid_f(a0[3]));
                    w.z = cvt_pk_bf16(bf_lo(gv.z) * sigmoid_f(a1[0]), bf_hi(gv.z) * sigmoid_f(a1[1])); w.w = cvt_pk_bf16(bf_lo(gv.w) * sigmoid_f(a1[2]), bf_hi(gv.w) * sigmoid_f(a1[3]));
                    *(u32x4*)(Z + off + bj * HALF) = w; } }
    }
};
struct EpiSwiGlu {
    static constexpr bool PERM = true, AFTER_DRAIN = false;
    bf16_t* FFo; int ldc;
    __device__ __forceinline__ void operator()(const f32x4 (&acc)[2][2][4][2], const Unit& u, int wr, int wc, int fr, int fq) const {
        const int row0 = u.pm * BM + wr * 64 + fr, col0 = u.pn * HALF + wc * 32 + 8 * fq;
#pragma unroll
        for (int ai = 0; ai < 2; ++ai)
#pragma unroll
            for (int m = 0; m < 4; ++m) { float o[8];
#pragma unroll
                for (int n = 0; n < 2; ++n)
#pragma unroll
                    for (int j = 0; j < 4; ++j) { const float gt = acc[ai][0][m][n][j], up = acc[ai][1][m][n][j]; o[n * 4 + j] = gt * sigmoid_f(gt) * up; }
                u32x4 w; w.x = cvt_pk_bf16(o[0], o[1]); w.y = cvt_pk_bf16(o[2], o[3]); w.z = cvt_pk_bf16(o[4], o[5]); w.w = cvt_pk_bf16(o[6], o[7]);
                *(u32x4*)(FFo + (size_t)(row0 + ai * HALF + m * 16) * ldc + col0) = w; }
    }
};
constexpr int S5_R = 1026;
struct EpiS5a {
    static constexpr bool PERM = false, AFTER_DRAIN = false;
    float* Sloc;
    __device__ __forceinline__ void operator()(const f32x4 (&acc)[2][2][4][2], const Unit& u, int wr, int wc, int fr, int fq) const {
        const int g = u.pn, rt = u.pm - 5 * g, col0 = wc * 32 + 4 * fq;
#pragma unroll
        for (int ai = 0; ai < 2; ++ai)
#pragma unroll
            for (int m = 0; m < 4; ++m) { const int rr = rt * BM + ai * HALF + wr * 64 + m * 16 + fr; if (rr < S5_R) { float* rowp = Sloc + ((size_t)g * S5_R + rr) * 256 + col0;
#pragma unroll
                for (int bj = 0; bj < 2; ++bj)
#pragma unroll
                    for (int n = 0; n < 2; ++n) *(f32x4*)(rowp + bj * HALF + n * 16) = acc[ai][bj][m][n]; } }
    }
};
struct EpiS5c {
    static constexpr bool PERM = true, AFTER_DRAIN = false;
    const float* hreal; const float* hmeta; const float* dskip; bf16_t* Gb;
    __device__ __forceinline__ void operator()(const f32x4 (&acc)[2][2][4][2], const Unit& u, int wr, int wc, int fr, int fq) const {
        const int g = u.pn, rt = u.pm - 5 * g, ch = 16 * g + 8 * (fq & 1);
        const f32x4 d0 = *(const f32x4*)(dskip + ch), d1 = *(const f32x4*)(dskip + ch + 4);
#pragma unroll
        for (int ai = 0; ai < 2; ++ai)
#pragma unroll
            for (int m = 0; m < 4; ++m) { const int rr = rt * BM + ai * HALF + wr * 64 + m * 16 + fr; if (rr < S5_R) {
#pragma unroll
                for (int bj = 0; bj < 2; ++bj) { const int t = 8 * bj + 2 * wc + (fq >> 1), tok = 16 * rr + t;
                    const float* hp = (tok < MREAL ? hreal + (size_t)tok * 1024 : hmeta + (size_t)(tok - MREAL) * 1024) + ch;
                    const f32x4 h0 = *(const f32x4*)hp, h1 = *(const f32x4*)(hp + 4);
                    const f32x4 y0 = acc[ai][bj][m][0] + d0 * h0, y1 = acc[ai][bj][m][1] + d1 * h1;
                    const f32x2 a = gelu_pk((f32x2){y0[0], y0[1]}), b = gelu_pk((f32x2){y0[2], y0[3]}), c = gelu_pk((f32x2){y1[0], y1[1]}), e = gelu_pk((f32x2){y1[2], y1[3]});
                    u32x4 w; w.x = cvt_pk_bf16(a.x, a.y); w.y = cvt_pk_bf16(b.x, b.y); w.z = cvt_pk_bf16(c.x, c.y); w.w = cvt_pk_bf16(e.x, e.y);
                    *(u32x4*)(Gb + (size_t)tok * 1024 + ch) = w; } } }
    }
};
struct S5Order {
    int G, c; long arow_bytes, brow_bytes;
    __device__ __forceinline__ bool next(int i, Unit& u) const { const int L = i * G + c; if (L >= 320) return false; const int g = L / 5, rt = L - 5 * g;
        u.pm = L; u.pn = g; u.aoff = ((long)g * S5_R + rt * BM) * arow_bytes; u.boff = (long)g * BM * brow_bytes; return true; }
    __device__ __forceinline__ void a_ready(const Unit&) const {}
    __device__ __forceinline__ void done(const Unit&) const {}
};
template <class Epi, class Sched, bool ALIGN_EPI = false, bool SP2 = false>
__device__ __forceinline__ void gemm_phase(PG8_LAS unsigned char* lds, const Gemm g, const Sched& S, const Epi& E) {
    const int tid = threadIdx.x, wid = __builtin_amdgcn_readfirstlane(tid >> 6), lane = tid & 63, wr = wid >> 2, wc = wid & 3, fr = lane & 15, fq = lane >> 4;
    const int K = g.K, nt = K / BK;
    unsigned voffA[2], voffB[2];
#pragma unroll
    for (int i = 0; i < 2; ++i) { int R, C; stage_rc(tid * 16 + i * 8192, R, C); const int Rb = Epi::PERM ? ((R & ~31) + perm32(R & 31)) : R;
        voffA[i] = (unsigned)(R * g.lda + C) * 2u; voffB[i] = (unsigned)(Rb * K + C) * 2u; }
    const size_t kstep = (size_t)(BK * 2);
    const size_t hstepA = (size_t)HALF * g.lda * 2, hstepB = (size_t)HALF * K * 2;
    const unsigned ldsw = (unsigned)wid * 1024u;
    const int aoff = lds_byte(wr * 64 + fr, fq * 8), boff = lds_byte(wc * 32 + fr, fq * 8);
#define PG8_SA(b, h) (((b) * 2 + (h)) * HTB)
#define PG8_SB(b, h) ((4 + (b) * 2 + (h)) * HTB)
#define PG8_STAGE(bufoff, gbase, voff) do { _Pragma("unroll") for (int _i = 0; _i < 2; ++_i) \
        __builtin_amdgcn_global_load_lds((const unsigned*)((const char*)(gbase) + (voff)[_i]), (PG8_LAS unsigned*)(lds + (bufoff) + ldsw + _i * 8192), 16, 0, 0); } while (0)
#define PG8_LDA(dst, b, h) do { _Pragma("unroll") for (int m = 0; m < 4; ++m) _Pragma("unroll") for (int k = 0; k < 2; ++k) dst[m][k] = *(const PG8_LAS bf16x8*)(lds + PG8_SA(b, h) + aoff + m * 2048 + k * 1024); } while (0)
#define PG8_LDB(dst, b, h) do { _Pragma("unroll") for (int n = 0; n < 2; ++n) _Pragma("unroll") for (int k = 0; k < 2; ++k) dst[n][k] = *(const PG8_LAS bf16x8*)(lds + PG8_SB(b, h) + boff + n * 2048 + k * 1024); } while (0)
#define PG8_MMA(ai, bj, At, Bt) do { __builtin_amdgcn_s_setprio(1); _Pragma("unroll") for (int m = 0; m < 4; ++m) _Pragma("unroll") for (int n = 0; n < 2; ++n) _Pragma("unroll") for (int k = 0; k < 2; ++k) \
        acc[ai][bj][m][n] = __builtin_amdgcn_mfma_f32_16x16x32_bf16(Bt[n][k], At[m][k], acc[ai][bj][m][n], 0, 0, 0); __builtin_amdgcn_s_setprio(0); } while (0)
#define PG8_WAIT_V(n) asm volatile("s_waitcnt vmcnt(" #n ")" ::: "memory")
#define PG8_WAIT_L(n) asm volatile("s_waitcnt lgkmcnt(" #n ")" ::: "memory")
#define PG8_BAR __builtin_amdgcn_s_barrier()
#define PG8_SCHED __builtin_amdgcn_sched_barrier(0)
    Unit cur, nxt; int ui = 0;
    if (!S.next(0, cur)) return;
    f32x4 acc[2][2][4][2];
#pragma unroll
    for (int a = 0; a < 2; ++a)
#pragma unroll
        for (int b = 0; b < 2; ++b)
#pragma unroll
            for (int m = 0; m < 4; ++m)
#pragma unroll
                for (int n = 0; n < 2; ++n) acc[a][b][m][n] = (f32x4){0.f, 0.f, 0.f, 0.f};
    bf16x8 At[4][2], B0[2][2], B1[2][2];
    const char* cA = (const char*)g.A + cur.aoff; const char* cB = (const char*)g.Bt + cur.boff;
    S.a_ready(cur);
    if constexpr (SP2) {
        PG8_STAGE(PG8_SB(0, 0), cB, voffB); PG8_STAGE(PG8_SB(0, 1), cB + hstepB, voffB); PG8_STAGE(PG8_SA(0, 0), cA, voffA); PG8_STAGE(PG8_SA(0, 1), cA + hstepA, voffA);
        if (wr == 1) PG8_BAR;
        PG8_WAIT_V(2); PG8_BAR;
        PG8_STAGE(PG8_SB(1, 0), cB + kstep, voffB); PG8_STAGE(PG8_SA(1, 0), cA + kstep, voffA); PG8_STAGE(PG8_SB(1, 1), cB + hstepB + kstep, voffB);
        PG8_WAIT_V(6); PG8_BAR;
    } else {
        PG8_STAGE(PG8_SB(0, 0), cB, voffB); PG8_STAGE(PG8_SA(0, 0), cA, voffA); PG8_STAGE(PG8_SB(0, 1), cB + hstepB, voffB); PG8_STAGE(PG8_SA(0, 1), cA + hstepA, voffA);
        if (wr == 1) PG8_BAR;
        PG8_WAIT_V(4); PG8_BAR;
        PG8_STAGE(PG8_SB(1, 0), cB + kstep, voffB); PG8_STAGE(PG8_SA(1, 0), cA + kstep, voffA); PG8_STAGE(PG8_SB(1, 1), cB + hstepB + kstep, voffB);
        PG8_WAIT_V(6); PG8_BAR;
    }
    for (;;) {
        const bool has_next = S.next(ui + 1, nxt);
        const char* nA = has_next ? (const char*)g.A + nxt.aoff : cA; const char* nB = has_next ? (const char*)g.Bt + nxt.boff : cB;
        for (int t = 0; t < nt; t += 2) {
            const bool last = (t == nt - 2);
            const char* a1 = cA + (size_t)(t + 1) * kstep;
            const char* a2 = last ? nA : cA + (size_t)(t + 2) * kstep; const char* b2 = last ? nB : cB + (size_t)(t + 2) * kstep;
            const char* a3 = a2 + kstep; const char* b3 = b2 + kstep;
            if (last && has_next) S.a_ready(nxt);
            if constexpr (SP2) {
            PG8_LDB(B0, 0, 0); PG8_LDB(B1, 0, 1); PG8_SCHED; PG8_LDA(At, 0, 0); PG8_STAGE(PG8_SA(1, 1), a1 + hstepA, voffA);
            PG8_WAIT_V(8); PG8_WAIT_L(0); PG8_BAR; PG8_MMA(0, 0, At, B0); PG8_MMA(0, 1, At, B1); PG8_BAR; PG8_SCHED;
            PG8_LDA(At, 0, 1); PG8_STAGE(PG8_SB(0, 0), b2, voffB); PG8_STAGE(PG8_SB(0, 1), b2 + hstepB, voffB); PG8_STAGE(PG8_SA(0, 0), a2, voffA);
            PG8_WAIT_V(8); PG8_WAIT_L(0); PG8_BAR; PG8_MMA(1, 0, At, B0); PG8_MMA(1, 1, At, B1); PG8_BAR; PG8_SCHED;
            PG8_LDB(B0, 1, 0); PG8_LDB(B1, 1, 1); PG8_SCHED; PG8_LDA(At, 1, 0); PG8_STAGE(PG8_SA(0, 1), a2 + hstepA, voffA);
            PG8_WAIT_V(8); PG8_WAIT_L(0); PG8_BAR; PG8_MMA(0, 0, At, B0); PG8_MMA(0, 1, At, B1); PG8_BAR; PG8_SCHED;
            PG8_LDA(At, 1, 1); PG8_STAGE(PG8_SB(1, 0), b3, voffB); PG8_STAGE(PG8_SB(1, 1), b3 + hstepB, voffB); PG8_STAGE(PG8_SA(1, 0), a3, voffA);
            PG8_WAIT_V(8); PG8_WAIT_L(0); PG8_BAR; PG8_MMA(1, 0, At, B0); PG8_MMA(1, 1, At, B1); PG8_BAR; PG8_SCHED;
            } else {
            PG8_LDB(B0, 0, 0); PG8_SCHED; PG8_LDA(At, 0, 0); PG8_STAGE(PG8_SA(1, 1), a1 + hstepA, voffA);
            PG8_WAIT_L(8); PG8_BAR; PG8_WAIT_L(0); PG8_MMA(0, 0, At, B0); PG8_BAR; PG8_SCHED;
            PG8_LDB(B1, 0, 1); PG8_STAGE(PG8_SB(0, 0), b2, voffB);
            PG8_BAR; PG8_WAIT_L(0); PG8_MMA(0, 1, At, B1); PG8_BAR;
            PG8_LDA(At, 0, 1); PG8_STAGE(PG8_SA(0, 0), a2, voffA);
            PG8_BAR; PG8_WAIT_L(0); PG8_MMA(1, 0, At, B0); PG8_BAR; PG8_SCHED;
            PG8_STAGE(PG8_SB(0, 1), b2 + hstepB, voffB);
            PG8_WAIT_V(6); PG8_BAR; PG8_MMA(1, 1, At, B1); PG8_BAR;
            PG8_LDB(B0, 1, 0); PG8_SCHED; PG8_LDA(At, 1, 0); PG8_STAGE(PG8_SA(0, 1), a2 + hstepA, voffA);
            PG8_WAIT_L(8); PG8_BAR; PG8_WAIT_L(0); PG8_MMA(0, 0, At, B0); PG8_BAR; PG8_SCHED;
            PG8_LDB(B1, 1, 1); PG8_STAGE(PG8_SB(1, 0), b3, voffB);
            PG8_BAR; PG8_WAIT_L(0); PG8_MMA(0, 1, At, B1); PG8_BAR;
            PG8_LDA(At, 1, 1); PG8_STAGE(PG8_SA(1, 0), a3, voffA);
            PG8_BAR; PG8_WAIT_L(0); PG8_MMA(1, 0, At, B0); PG8_BAR; PG8_SCHED;
            PG8_STAGE(PG8_SB(1, 1), b3 + hstepB, voffB);
            PG8_WAIT_V(6); PG8_BAR; PG8_MMA(1, 1, At, B1); PG8_BAR;
            }
        }
        if constexpr (ALIGN_EPI) { if (wr == 0) PG8_BAR; }
        if constexpr (!Epi::AFTER_DRAIN) { E(acc, cur, wr, wc, fr, fq); S.done(cur); }
        if (!has_next) break;
#pragma unroll
        for (int a = 0; a < 2; ++a)
#pragma unroll
            for (int b = 0; b < 2; ++b)
#pragma unroll
                for (int m = 0; m < 4; ++m)
#pragma unroll
                    for (int n = 0; n < 2; ++n) acc[a][b][m][n] = (f32x4){0.f, 0.f, 0.f, 0.f};
        cur = nxt; cA = nA; cB = nB; ++ui;
        if constexpr (ALIGN_EPI) { if (wr == 1) PG8_BAR; }
    }
    PG8_WAIT_V(0);
    if constexpr (!ALIGN_EPI) { if (wr == 0) PG8_BAR; }
    PG8_BAR;
    if constexpr (Epi::AFTER_DRAIN) { E.fused(acc, cur, wr, wc, fr, fq, lds, wid, lane); S.done(cur); }
#undef PG8_SA
#undef PG8_SB
#undef PG8_STAGE
#undef PG8_LDA
#undef PG8_LDB
#undef PG8_MMA
#undef PG8_WAIT_V
#undef PG8_WAIT_L
#undef PG8_BAR
#undef PG8_SCHED
}
}

#ifndef PG8_SP2
#define PG8_SP2 true
#endif
#ifndef PG8_ALIGN
#define PG8_ALIGN true
#endif
#include <hip/hip_bf16.h>
#include <cmath>
namespace attn_body {
using bf16=__hip_bfloat16;
using bf16x8=__attribute__((ext_vector_type(8)))short;
using s16x4=__attribute__((ext_vector_type(4)))short;
using f32x16=__attribute__((ext_vector_type(16)))float;
using u32x4=__attribute__((ext_vector_type(4)))unsigned;
constexpr int NHEAD=16,D=64,PQ=1536,PO=1024,NT=130;
constexpr int NW=8,QBLK=32,QB=QBLK*NW,KVBLK=64;
__device__ __forceinline__ int crow(int r,int hi){return (r&3)+8*(r>>2)+4*hi;}
#define SBAR() __builtin_amdgcn_sched_barrier(0)
constexpr int NSLOT=3, SLOTB=8192;
constexpr int LDS_K=0, LDS_V=NSLOT*SLOTB, LDS_WS=2*NSLOT*SLOTB, LDS_OST=LDS_WS+NW*64*4, LDS_BYTES=LDS_OST+NW*4096;
constexpr float C2=0.125f*1.4426950408889634f;
__device__ __forceinline__ void glds16(const void*gsrc,unsigned lds_dst){unsigned keep;
  asm volatile("s_mov_b32 %0, m0\n\ts_mov_b32 m0, %2\n\ts_nop 0\n\tglobal_load_lds_dwordx4 %1, off\n\ts_mov_b32 m0, %0":"=&s"(keep):"v"(gsrc),"s"(lds_dst):"memory");}
__device__ __forceinline__ float max3f(float a,float b,float c){float r;asm("v_max3_f32 %0, %1, %2, %3":"=v"(r):"v"(a),"v"(b),"v"(c));return r;}
__device__ __forceinline__ float max2f(float a,float b){float r;asm("v_max_f32_e32 %0, %1, %2":"=v"(r):"v"(a),"v"(b));return r;}
__device__ __forceinline__ float fadd_s(float a,float b){float r;asm("v_add_f32_e32 %0, %1, %2":"=v"(r):"v"(a),"v"(b));return r;}
__device__ __forceinline__ float fsub_s(float a,float b){float r;asm("v_sub_f32_e32 %0, %1, %2":"=v"(r):"v"(a),"v"(b));return r;}
typedef float f32x2_t __attribute__((ext_vector_type(2))); typedef __bf16 bf16x2_t __attribute__((ext_vector_type(2)));
__device__ __forceinline__ unsigned cvtpk_s(float lo,float hi){f32x2_t v={lo,hi};bf16x2_t b=__builtin_convertvector(v,bf16x2_t);return __builtin_bit_cast(unsigned,b);}
#define WAIT_BAR(N) asm volatile("s_waitcnt vmcnt(" #N ") lgkmcnt(0)\n\ts_barrier":::"memory")

__device__ __forceinline__ void qkt(f32x16&p0,f32x16&p1,const char*Kslot,const bf16x8*qr,const f32x16&negm,int r32,int hi){
  const char*kb=Kslot+hi*1024+r32*16;
  #pragma unroll
  for(int d0=0;d0<4;++d0){
    const bf16x8 b0=*reinterpret_cast<const bf16x8*>(kb+d0*2048);
    const bf16x8 b1=*reinterpret_cast<const bf16x8*>(kb+d0*2048+512);
    if(d0==0){p0=__builtin_amdgcn_mfma_f32_32x32x16_bf16(b0,qr[0],negm,0,0,0);p1=__builtin_amdgcn_mfma_f32_32x32x16_bf16(b1,qr[0],negm,0,0,0);}
    else{p0=__builtin_amdgcn_mfma_f32_32x32x16_bf16(b0,qr[d0],p0,0,0,0);p1=__builtin_amdgcn_mfma_f32_32x32x16_bf16(b1,qr[d0],p1,0,0,0);}}
}
typedef __attribute__((address_space(3))) const char* lds_cptr;
typedef short v4i16_t __attribute__((ext_vector_type(4)));
__device__ __forceinline__ void kload8(bf16x8*kf,lds_cptr kp){
  kf[0]=*(const __attribute__((address_space(3))) bf16x8*)(kp);      kf[1]=*(const __attribute__((address_space(3))) bf16x8*)(kp+512);
  kf[2]=*(const __attribute__((address_space(3))) bf16x8*)(kp+2048); kf[3]=*(const __attribute__((address_space(3))) bf16x8*)(kp+2560);
  kf[4]=*(const __attribute__((address_space(3))) bf16x8*)(kp+4096); kf[5]=*(const __attribute__((address_space(3))) bf16x8*)(kp+4608);
  kf[6]=*(const __attribute__((address_space(3))) bf16x8*)(kp+6144); kf[7]=*(const __attribute__((address_space(3))) bf16x8*)(kp+6656);
}
__device__ __forceinline__ void kload2(bf16x8*kf,lds_cptr kp,int j){ kf[2*j]=*(const __attribute__((address_space(3))) bf16x8*)(kp+j*2048); kf[2*j+1]=*(const __attribute__((address_space(3))) bf16x8*)(kp+j*2048+512); }
__device__ __forceinline__ s16x4 vtr(lds_cptr p){ return __builtin_bit_cast(s16x4,__builtin_amdgcn_ds_read_tr16_b64_v4i16((__attribute__((address_space(3))) v4i16_t*)p)); }
__device__ __forceinline__ float rowmax(const f32x16&p0,const f32x16&p1){
  float a=max3f(p0[0],p0[1],p1[0]),b=max3f(p0[2],p0[3],p1[1]);a=max3f(a,p1[2],p1[3]);
  #pragma unroll
  for(int r=4;r<16;r+=4){a=max3f(a,p0[r],p0[r+1]);b=max3f(b,p0[r+2],p0[r+3]);a=max3f(a,p1[r],p1[r+1]);b=max3f(b,p1[r+2],p1[r+3]);}
  const float m=max2f(a,b);
  auto rr=__builtin_amdgcn_permlane32_swap(__float_as_uint(m),__float_as_uint(m),false,false);
  return max2f(__uint_as_float(rr[0]),__uint_as_float(rr[1]));
}
__device__ __forceinline__ void pv(f32x16*o,int vb,bf16x8 pa0,bf16x8 pa1,bf16x8 pa2,bf16x8 pa3){
  #pragma unroll
  for(int d0=0;d0<2;++d0){s16x4 lo[4],hi[4];
    #pragma unroll
    for(int ks=0;ks<4;++ks){
      asm volatile("ds_read_b64_tr_b16 %0,%1 offset:%c2":"=&v"(lo[ks]):"v"(vb),"i"(d0*4096+ks*1024):"memory");
      asm volatile("ds_read_b64_tr_b16 %0,%1 offset:%c2":"=&v"(hi[ks]):"v"(vb),"i"(d0*4096+ks*1024+512):"memory");}
    asm volatile("s_waitcnt lgkmcnt(0)":::"memory");SBAR();
    #define PK(k) (bf16x8){lo[k][0],lo[k][1],lo[k][2],lo[k][3],hi[k][0],hi[k][1],hi[k][2],hi[k][3]}
    o[d0]=__builtin_amdgcn_mfma_f32_32x32x16_bf16(pa0,PK(0),o[d0],0,0,0);
    o[d0]=__builtin_amdgcn_mfma_f32_32x32x16_bf16(pa1,PK(1),o[d0],0,0,0);
    o[d0]=__builtin_amdgcn_mfma_f32_32x32x16_bf16(pa2,PK(2),o[d0],0,0,0);
    o[d0]=__builtin_amdgcn_mfma_f32_32x32x16_bf16(pa3,PK(3),o[d0],0,0,0);
    #undef PK
  }
}

#ifndef ATTN_STORE16
#define ATTN_STORE16(p,v) (*(u32x4*)(p)=(v))
#endif
__device__ __forceinline__ void tmask(f32x16&p0,f32x16&p1,bool full){ const float NEG=-INFINITY;
  #pragma unroll
  for(int r=0;r<16;++r){ p1[r]=NEG; if(full||r>=8)p0[r]=NEG; } }
template<int THRL> __device__ __forceinline__ void attn_unit(const bf16*Q0,const bf16*__restrict__ Kh,const bf16*__restrict__ Vh,long metarow,bf16*O0,int nvalid,char*shm){
  const int tid=threadIdx.x,lane=tid&63,r32=lane&31,hi=lane>>5; const int wid=__builtin_amdgcn_readfirstlane(tid>>6);
  const bf16*Qw=Q0+(long)(wid*QBLK)*PQ;
  const unsigned lds0=(unsigned)(uintptr_t)shm;
  float*wsf=(float*)(shm+LDS_WS)+wid*64;
  const bf16*ksrc=Kh+(long)lane*PQ+wid*8;
  const bf16*vsrc=Vh+(long)(16*(wid&3)+(lane>>2))*PQ+(wid>>2)*32+(lane&3)*8;
  const unsigned kdst=lds0+LDS_K+wid*1024, vdst=lds0+LDS_V+wid*1024;
  #define TOFF(t) (((t)<NT-2?(long)(t)*KVBLK:metarow)*PQ)
  #define DMA_K(t,slot) glds16(ksrc+TOFF(t),(unsigned)__builtin_amdgcn_readfirstlane(kdst+(slot)))
  #define DMA_V(t,slot) glds16(vsrc+TOFF(t),(unsigned)__builtin_amdgcn_readfirstlane(vdst+(slot)))
  const int vb0=(int)(lds0+LDS_V)+((lane>>4)&1)*32+(lane&3)*8+(4*hi+((lane&15)>>2))*64;
  const char*Kbase=shm+LDS_K; bf16x8 kf[8];
  const lds_cptr shm3=(lds_cptr)shm; const lds_cptr kp0=shm3+LDS_K+hi*1024+r32*16; const lds_cptr vp0=shm3+LDS_V+((lane>>4)&1)*32+(lane&3)*8+(4*hi+((lane&15)>>2))*64;
  DMA_K(0,0);DMA_V(0,0);DMA_K(1,SLOTB);
  bf16x8 qr[4];
  #pragma unroll
  for(int d0=0;d0<4;++d0)qr[d0]=*reinterpret_cast<const bf16x8*>(&Qw[(long)r32*PQ+d0*16+hi*8]);
  float mhat=0.f,l_reg=0.f;f32x16 o[2];o[0]=f32x16{};o[1]=f32x16{};f32x16 negm=f32x16{};asm volatile("":"+v"(negm));
  #define CMASK(P0,P1,t) do{ if((t)>=NT-2) tmask(P0,P1,(t)==NT-1); }while(0)
  bool resc=false;
  #define START(P0,P1) do{ const float rm=rowmax(P0,P1); resc=false; \
    { const float dl=rm; mhat=fadd_s(mhat,dl); \
      _Pragma("unroll") for(int r=0;r<16;++r){P0[r]=fsub_s(P0[r],dl);P1[r]=fsub_s(P1[r],dl);} \
      _Pragma("unroll") for(int r=0;r<16;++r)negm[r]=-mhat; asm volatile("":"+v"(negm)); } \
    _Pragma("unroll") for(int r=0;r<16;++r)P0[r]=__builtin_amdgcn_exp2f(P0[r]); }while(0)
  #define RESC() do{ if(resc){ asm volatile("s_waitcnt lgkmcnt(0)":::"memory"); \
      _Pragma("unroll") for(int d_=0;d_<2;++d_) _Pragma("unroll") for(int r=0;r<16;++r)o[d_][r]*=wsf[crow(r,hi)]; } }while(0)
  f32x16 pA0,pA1,pB0,pB1;
  int sl_prev=0,sl_cur=0,sl_next=SLOTB;
  #define ROT() do{sl_prev=sl_cur;sl_cur=sl_next;sl_next=(sl_next==(NSLOT-1)*SLOTB)?0:sl_next+SLOTB;}while(0)
  DMA_K(2,2*SLOTB);
  WAIT_BAR(3);
  qkt(pA0,pA1,Kbase,qr,negm,r32,hi);asm volatile("s_nop 15\n\ts_nop 7":"+v"(pA0),"+v"(pA1));CMASK(pA0,pA1,0);
  START(pA0,pA1);
  _Pragma("unroll") for(int r=0;r<16;++r)pA1[r]=__builtin_amdgcn_exp2f(pA1[r]);
  WAIT_BAR(0);
  DMA_K(3,0);DMA_V(1,SLOTB);
  ROT();
  kload8(kf,kp0+sl_cur);
  WAIT_BAR(2);
  s16x4 vlo[8],vhi[8]; u32x4 pw0,pw1,pw2,pw3;
  #define PKW(P,B) cvtpk_s(P[B],P[B+1])
  #define PAF(k) __builtin_bit_cast(bf16x8,pw##k)
  #define VFR(i) (bf16x8){vlo[i][0],vlo[i][1],vlo[i][2],vlo[i][3],vhi[i][0],vhi[i][1],vhi[i][2],vhi[i][3]}
  #define PIN(x) asm volatile("":"+v"(x))
  #define MX3(a,b,c) __builtin_fmaxf(__builtin_fmaxf((a),(b)),(c))
  #define GAPA(MF,A0,A1,A2,A3,W0,W1,PW) do{ MF; sacc+=A0; sacc+=A1; sacc+=A2; sacc+=A3; PIN(sacc); W0; W1; PIN(PW); SBAR(); }while(0)
  #define EX(v) __builtin_amdgcn_exp2f(v)
  #define GAPB(MF,X,B) do{ MF; X[B]=EX(X[B]); X[B+1]=EX(X[B+1]); X[B+2]=EX(X[B+2]); X[B+3]=EX(X[B+3]); PIN(X); SBAR(); }while(0)
  #define VRD(i) do{ vlo[i]=vtr(vp_+(((i)>>2)*4096+((i)&3)*1024)); vhi[i]=vtr(vp_+(((i)>>2)*4096+((i)&3)*1024+512)); }while(0)
  #define KRD(G,j) do{ if(G){ kload2(kf,kp0+sl_next,j); SBAR(); } }while(0)
  #define STEP(C0,C1,P0,P1,t,GK,GV,GL) do{ SBAR(); \
    const lds_cptr vp_=vp0+sl_prev; \
    VRD(0); SBAR(); float sacc=(P0[0]+P0[1]); \
    GAPA(C0=__builtin_amdgcn_mfma_f32_32x32x16_bf16(kf[0],qr[0],negm,0,0,0), P0[2],P0[3],P0[4],P0[5],     pw0[0]=PKW(P0,0), pw0[1]=PKW(P0,2), pw0); \
    VRD(4); SBAR(); GAPA(C1=__builtin_amdgcn_mfma_f32_32x32x16_bf16(kf[1],qr[0],negm,0,0,0), P0[6],P0[7],P0[8],P0[9],     pw0[2]=PKW(P0,4), pw0[3]=PKW(P0,6), pw0); \
    VRD(1); SBAR(); GAPA(C0=__builtin_amdgcn_mfma_f32_32x32x16_bf16(kf[2],qr[1],C0,0,0,0),   P0[10],P0[11],P0[12],P0[13], pw1[0]=PKW(P0,8), pw1[1]=PKW(P0,10), pw1); \
    VRD(5); SBAR(); GAPA(C1=__builtin_amdgcn_mfma_f32_32x32x16_bf16(kf[3],qr[1],C1,0,0,0),   P0[14],P0[15],P1[0],P1[1],   pw1[2]=PKW(P0,12),pw1[3]=PKW(P0,14), pw1); \
    VRD(2); SBAR(); GAPA(C0=__builtin_amdgcn_mfma_f32_32x32x16_bf16(kf[4],qr[2],C0,0,0,0),   P1[2],P1[3],P1[4],P1[5],     pw2[0]=PKW(P1,0), pw2[1]=PKW(P1,2), pw2); \
    VRD(6); SBAR(); GAPA(C1=__builtin_amdgcn_mfma_f32_32x32x16_bf16(kf[5],qr[2],C1,0,0,0),   P1[6],P1[7],P1[8],P1[9],     pw2[2]=PKW(P1,4), pw2[3]=PKW(P1,6), pw2); \
    VRD(3); SBAR(); GAPA(C0=__builtin_amdgcn_mfma_f32_32x32x16_bf16(kf[6],qr[3],C0,0,0,0),   P1[10],P1[11],P1[12],P1[13], pw3[0]=PKW(P1,8), pw3[1]=PKW(P1,10), pw3); \
    VRD(7); SBAR(); GAPA(C1=__builtin_amdgcn_mfma_f32_32x32x16_bf16(kf[7],qr[3],C1,0,0,0),   P1[14],P1[15],0.f,0.f,       pw3[2]=PKW(P1,12),pw3[3]=PKW(P1,14), pw3); \
    l_reg+=sacc; \
    if(GK){DMA_K((t)+3,sl_cur);} if(GV){DMA_V((t)+1,sl_next);} \
    CMASK(C0,C1,t); \
    { float a=MX3(C0[0],C0[1],C1[0]),b=MX3(C0[2],C0[3],C1[1]); a=MX3(a,C1[2],C1[3]); \
      _Pragma("unroll") for(int r=4;r<16;r+=4){a=MX3(a,C0[r],C0[r+1]);b=MX3(b,C0[r+2],C0[r+3]);a=MX3(a,C1[r],C1[r+1]);b=MX3(b,C1[r+2],C1[r+3]);} \
      float rm=__builtin_fmaxf(a,b); { auto rr=__builtin_amdgcn_permlane32_swap(__float_as_uint(rm),__float_as_uint(rm),false,false); rm=__builtin_fmaxf(__uint_as_float(rr[0]),__uint_as_float(rr[1])); } \
      resc=false; \
      if(__builtin_expect(__any(rm>(float)THRL),0)){ const float dl=__builtin_fmaxf(rm,0.f); mhat+=dl; \
        _Pragma("unroll") for(int r=0;r<16;++r){C0[r]-=dl;C1[r]-=dl;} \
        _Pragma("unroll") for(int r=0;r<16;++r)negm[r]=-mhat; asm volatile("":"+v"(negm)); \
        const float f=__builtin_amdgcn_exp2f(-dl); l_reg*=f; if(hi==0)wsf[r32]=f; resc=true; } } \
    SBAR(); \
    GAPB(o[0]=__builtin_amdgcn_mfma_f32_32x32x16_bf16(PAF(0),VFR(0),o[0],0,0,0), C0,0); \
    GAPB(o[1]=__builtin_amdgcn_mfma_f32_32x32x16_bf16(PAF(0),VFR(4),o[1],0,0,0), C0,4); \
    KRD(GL,0); GAPB(o[0]=__builtin_amdgcn_mfma_f32_32x32x16_bf16(PAF(1),VFR(1),o[0],0,0,0), C0,8); \
    KRD(GL,1); GAPB(o[1]=__builtin_amdgcn_mfma_f32_32x32x16_bf16(PAF(1),VFR(5),o[1],0,0,0), C0,12); \
    KRD(GL,2); GAPB(o[0]=__builtin_amdgcn_mfma_f32_32x32x16_bf16(PAF(2),VFR(2),o[0],0,0,0), C1,0); \
    KRD(GL,3); GAPB(o[1]=__builtin_amdgcn_mfma_f32_32x32x16_bf16(PAF(2),VFR(6),o[1],0,0,0), C1,4); \
    GAPB(o[0]=__builtin_amdgcn_mfma_f32_32x32x16_bf16(PAF(3),VFR(3),o[0],0,0,0), C1,8); \
    GAPB(o[1]=__builtin_amdgcn_mfma_f32_32x32x16_bf16(PAF(3),VFR(7),o[1],0,0,0), C1,12); \
    }while(0)
  int t=1;
  #undef CMASK
  #define CMASK(P0,P1,t) do{}while(0)
  for(;t+5<NT;t+=2){
    STEP(pB0,pB1,pA0,pA1,t,true,true,true);     WAIT_BAR(2); RESC(); ROT();
    STEP(pA0,pA1,pB0,pB1,t+1,true,true,true);   WAIT_BAR(2); RESC(); ROT();
  }
  #undef CMASK
  #define CMASK(P0,P1,t) do{ if((t)>=NT-2) tmask(P0,P1,(t)==NT-1); }while(0)
  #define ENDW(tt) do{ if((tt)+3<NT){WAIT_BAR(2);} else if((tt)+2<NT){WAIT_BAR(1);} else {WAIT_BAR(0);} }while(0)
  for(;t+1<NT;t+=2){
    STEP(pB0,pB1,pA0,pA1,t,(t+3<NT),(t+1<NT),(t+1<NT));       ENDW(t);   RESC(); ROT();
    STEP(pA0,pA1,pB0,pB1,t+1,(t+4<NT),(t+2<NT),(t+2<NT));     ENDW(t+1); RESC(); ROT();
  }
  STEP(pB0,pB1,pA0,pA1,NT-1,false,false,false); RESC();
  { float sacc=pB0[0]+pB0[1]; _Pragma("unroll") for(int r=2;r<16;++r)sacc+=pB0[r]; _Pragma("unroll") for(int r=0;r<16;++r)sacc+=pB1[r]; l_reg+=sacc;
    pw0=(u32x4){PKW(pB0,0),PKW(pB0,2),PKW(pB0,4),PKW(pB0,6)};pw1=(u32x4){PKW(pB0,8),PKW(pB0,10),PKW(pB0,12),PKW(pB0,14)};pw2=(u32x4){PKW(pB1,0),PKW(pB1,2),PKW(pB1,4),PKW(pB1,6)};pw3=(u32x4){PKW(pB1,8),PKW(pB1,10),PKW(pB1,12),PKW(pB1,14)};
    SBAR(); pv(o,vb0+sl_cur,PAF(0),PAF(1),PAF(2),PAF(3)); }
  #undef PKW
  #undef PAF
  #undef VFR
  #undef PIN
  #undef MX3
  #undef GAPA
  #undef GAPB
  #undef EX
  #undef VRD
  #undef KRD
  #undef STEP
  #undef ENDW
  {auto rr=__builtin_amdgcn_permlane32_swap(__float_as_uint(l_reg),__float_as_uint(l_reg),false,false);l_reg=__uint_as_float(rr[0])+__uint_as_float(rr[1]);}
  if(hi==0)wsf[32+r32]=l_reg;asm volatile("s_waitcnt lgkmcnt(0)":::"memory");
  float rli[16];
  #pragma unroll
  for(int r=0;r<16;++r)rli[r]=__builtin_amdgcn_rcpf(wsf[32+crow(r,hi)]);
  bf16*Ow=O0+(long)(wid*QBLK)*PO;
  { bf16*stg=(bf16*)(shm+LDS_OST)+wid*2048;
    #pragma unroll
    for(int r=0;r<16;++r){const int orow=crow(r,hi);
      #pragma unroll
      for(int d0=0;d0<2;++d0)stg[orow*64+d0*32+r32]=__float2bfloat16(o[d0][r]*rli[r]);}
    asm volatile("s_waitcnt lgkmcnt(0)":::"memory");
    #pragma unroll
    for(int i=0;i<4;++i){const int row=i*8+(lane>>3),ch=lane&7; const u32x4 v=*(const u32x4*)(stg+row*64+ch*8); if(wid*QBLK+row<nvalid)ATTN_STORE16(Ow+(long)row*PO+ch*8,v);} }
  asm volatile("s_waitcnt lgkmcnt(0)\n\ts_barrier":::"memory");
  #undef TOFF
  #undef DMA_K
  #undef DMA_V
  #undef CMASK
  #undef START
  #undef RESC
  #undef ROT
}
constexpr int ATTN_LDS_BYTES=LDS_BYTES;
#undef SBAR
#undef WAIT_BAR
}
namespace cg = cooperative_groups;
#define LAS __attribute__((address_space(3)))
typedef unsigned short bf16_t;
typedef float f32x4 __attribute__((ext_vector_type(4)));
typedef unsigned v4u __attribute__((ext_vector_type(4)));
constexpr int NWAVES = 8, NTHREADS = 512;
constexpr int D = 1024, FF = 2816, MREAL = 16384, MVALID = 16416, MPAD = 16640, QKVW = 1536, QKV_ROWS = 16704;
constexpr int S5R = 1026;
constexpr float LN_EPS = 1e-5f, QK_EPS = 1e-6f;
constexpr float DN_ALPHA = 1.681792830507429f;
constexpr size_t MiB = 1u << 20;
constexpr size_t WS_WMIX = 1 * MiB, WS_WGU = 7 * MiB, WS_WDN = 18 * MiB, WS_TMAT = 24 * MiB, WS_BPOW = 40 * MiB, WS_A16 = 48 * MiB, WS_HMETA = 49 * MiB, WS_HB = 50 * MiB, WS_X = 83 * MiB;
constexpr size_t WS_AG = WS_X, WS_SLOC = WS_X + 65 * MiB, WS_G = WS_SLOC, WS_Z = WS_G + 33 * MiB;
constexpr size_t WS_QKV = WS_X, WS_O = WS_X + 49 * MiB;
constexpr size_t WS_FF = WS_X;
constexpr size_t WS_END = 256 * MiB;
static_assert(WS_Z + 33 * MiB <= WS_END && WS_O + 33 * MiB <= WS_END && WS_FF + (size_t)MPAD * FF * 2 <= WS_END, "ws map");
static_assert((size_t)(64 * S5R + 256) * 1024 <= 65 * MiB && (size_t)64 * S5R * 1024 <= 65 * MiB && (size_t)QKV_ROWS * QKVW * 2 <= 49 * MiB && (size_t)MPAD * D * 2 <= 33 * MiB, "ws map 2");
constexpr int LDS_BYTES = 147456, RING_BYTES = 131072;

struct Args {
    const float *x, *meta, *lam_re, *lam_im, *log_dt, *b_re, *b_im, *c_re, *c_im, *s5d, *w_glu, *w_sout, *w_qkv, *q_gain, *k_gain, *w_aout, *w_gate, *w_up, *w_down, *ln_g, *ln_b;
    float* out; unsigned char* ws; int ph_lo, ph_hi;
};

__device__ __forceinline__ unsigned f2bf(float f) { unsigned u = __builtin_bit_cast(unsigned, f); return (u + 0x7fffu + ((u >> 16) & 1u)) >> 16; }
__device__ __forceinline__ unsigned pk2(float lo, float hi) { return f2bf(lo) | (f2bf(hi) << 16); }
__device__ __forceinline__ unsigned long long pk4(f32x4 v) { return (unsigned long long)pk2(v.x, v.y) | ((unsigned long long)pk2(v.z, v.w) << 32); }
__device__ __forceinline__ float wave_sum(float v) {
#pragma unroll
    for (int o = 1; o < 64; o <<= 1) v += __shfl_xor(v, o);
    return v;
}
#define LDS_WAIT() asm volatile("s_waitcnt lgkmcnt(0)" ::: "memory")

__device__ __forceinline__ void transpose_item(const float* W, int K, int N, bf16_t* WT, int mode, LAS float* scr, int item, int lane) {
    const int nblk = N / 32, kb = item / nblk, nb = item % nblk, k0 = 64 * kb, n0 = 32 * nb;
    const int orow0 = (mode == 0) ? n0 : ((n0 >> 7) * 256 + (mode - 1) * 128 + (n0 & 127));
#pragma unroll 8
    for (int i = 0; i < 32; ++i) { const int kk = 2 * i + (lane >> 5); scr[kk * 33 + (lane & 31)] = W[(size_t)(k0 + kk) * N + n0 + (lane & 31)]; }
    LDS_WAIT(); asm volatile("" ::: "memory");
    const int c = lane & 7;
#pragma unroll
    for (int j = 0; j < 4; ++j) { const int n = (lane >> 3) + 8 * j; const LAS float* s = scr + (8 * c) * 33 + n;
        v4u o; o.x = pk2(s[0 * 33], s[1 * 33]); o.y = pk2(s[2 * 33], s[3 * 33]); o.z = pk2(s[4 * 33], s[5 * 33]); o.w = pk2(s[6 * 33], s[7 * 33]);
        *(v4u*)(WT + (size_t)(orow0 + n) * K + k0 + 8 * c) = o; }
    LDS_WAIT(); asm volatile("" ::: "memory");
}
__device__ __forceinline__ void convert_weights(const Args& a, int which, int j, LAS unsigned char* lds, int gw, int ngw, int wave, int lane) {
    LAS float* scr = (LAS float*)(lds + wave * 16384);
    unsigned char* ws = a.ws;
    if (which == 0) {
        constexpr int I = (D / 64) * (D / 32);
        for (int it = gw; it < 2 * I; it += ngw) {
            if (it < I) transpose_item(a.w_glu + (size_t)j * D * D, D, D, (bf16_t*)(ws + WS_WMIX), 0, scr, it, lane);
            else transpose_item(a.w_sout + (size_t)j * D * D, D, D, (bf16_t*)(ws + WS_WMIX + 2 * MiB), 0, scr, it - I, lane);
        }
    } else if (which == 1) {
        constexpr int I1 = (D / 64) * (QKVW / 32), I2 = (D / 64) * (D / 32);
        for (int it = gw; it < I1 + I2; it += ngw) {
            if (it < I1) transpose_item(a.w_qkv + (size_t)j * D * QKVW, D, QKVW, (bf16_t*)(ws + WS_WMIX), 0, scr, it, lane);
            else transpose_item(a.w_aout + (size_t)j * D * D, D, D, (bf16_t*)(ws + WS_WMIX + 3 * MiB), 0, scr, it - I1, lane);
        }
    } else {
        constexpr int I1 = (D / 64) * (FF / 32), I3 = (FF / 64) * (D / 32);
        for (int it = gw; it < 2 * I1 + I3; it += ngw) {
            if (it < I1) transpose_item(a.w_gate + (size_t)j * D * FF, D, FF, (bf16_t*)(ws + WS_WGU), 1, scr, it, lane);
            else if (it < 2 * I1) transpose_item(a.w_up + (size_t)j * D * FF, D, FF, (bf16_t*)(ws + WS_WGU), 2, scr, it - I1, lane);
            else transpose_item(a.w_down + (size_t)j * FF * D, FF, D, (bf16_t*)(ws + WS_WDN), 0, scr, it - 2 * I1, lane);
        }
    }
}
__device__ __forceinline__ void s5_tables(const Args& a, int j, int g, LAS float* L, int tid) {
    LAS float* apw = L;
    LAS float* Bb = L + 4352;
    LAS float* Cc = Bb + 4096;
    LAS float* Kt = Cc + 4096;
    bf16_t* Tmat = (bf16_t*)(a.ws + WS_TMAT) + (size_t)g * 256 * 512;
    bf16_t* Bpow = (bf16_t*)(a.ws + WS_BPOW) + (size_t)g * 256 * 256;
    float* A16 = (float*)(a.ws + WS_A16);
    if (tid < 128) {
        const int dir = tid >> 6, p = tid & 63; const size_t gi = ((size_t)(j * 2 + dir) * 64 + g);
        const float lr = a.lam_re[gi * 64 + p], li = a.lam_im[gi * 64 + p], dt = expf(a.log_dt[gi]);
        const float mag = expf(lr * dt), abr = mag * cosf(li * dt), abi = mag * sinf(li * dt);
        const float nr = abr - 1.0f, ni = abi, den = lr * lr + li * li, cr = (nr * lr + ni * li) / den, ci = (ni * lr - nr * li) / den;
        float pr = 1.f, pi = 0.f;
        for (int k = 0; k <= 16; ++k) { apw[((dir * 17 + k) * 64 + p) * 2] = pr; apw[((dir * 17 + k) * 64 + p) * 2 + 1] = pi; const float t = pr * abr - pi * abi; pi = pr * abi + pi * abr; pr = t; }
        A16[((g * 2 + dir) * 64 + p) * 2] = apw[((dir * 17 + 16) * 64 + p) * 2]; A16[((g * 2 + dir) * 64 + p) * 2 + 1] = apw[((dir * 17 + 16) * 64 + p) * 2 + 1];
        for (int c = 0; c < 16; ++c) { const float br = a.b_re[(gi * 64 + p) * 16 + c], bi = a.b_im[(gi * 64 + p) * 16 + c];
            Bb[((dir * 64 + p) * 16 + c) * 2] = cr * br - ci * bi; Bb[((dir * 64 + p) * 16 + c) * 2 + 1] = cr * bi + ci * br; }
    }
    for (int q = 0; q < 4; ++q) { const int idx = tid + 512 * q, dir = idx >> 10, co = (idx >> 6) & 15, p = idx & 63; const size_t ci_ = (((size_t)(j * 2 + dir) * 64 + g) * 16 + co) * 64 + p;
        Cc[idx * 2] = a.c_re[ci_]; Cc[idx * 2 + 1] = a.c_im[ci_]; }
    __syncthreads();
    for (int q = 0; q < 16; ++q) { const int o = tid + 512 * q, dir = o >> 12, k = (o >> 8) & 15, co = (o >> 4) & 15, ci = o & 15; float s = 0.f;
        for (int p = 0; p < 64; ++p) { const float ar = apw[((dir * 17 + k) * 64 + p) * 2], ai = apw[((dir * 17 + k) * 64 + p) * 2 + 1], br = Bb[((dir * 64 + p) * 16 + ci) * 2], bi = Bb[((dir * 64 + p) * 16 + ci) * 2 + 1];
            const float wr = ar * br - ai * bi, wi = ar * bi + ai * br; s += Cc[((dir * 16 + co) * 64 + p) * 2] * wr - Cc[((dir * 16 + co) * 64 + p) * 2 + 1] * wi; }
        Kt[o] = s; }
    __syncthreads();
    { const int n = tid >> 1, half = tid & 1, t = n >> 4, co = n & 15; bf16_t* rowp = Tmat + (size_t)n * 512 + half * 256;
        if (half == 0) {
            for (int s = 0; s < 16; ++s) { float v[16];
#pragma unroll
                for (int ci = 0; ci < 16; ++ci) { float x = 0.f; if (s <= t) x += Kt[((0 * 16 + (t - s)) * 16 + co) * 16 + ci]; if (s >= t) x += Kt[((1 * 16 + (s - t)) * 16 + co) * 16 + ci]; v[ci] = x; }
                v4u o0, o1; o0.x = pk2(v[0], v[1]); o0.y = pk2(v[2], v[3]); o0.z = pk2(v[4], v[5]); o0.w = pk2(v[6], v[7]); o1.x = pk2(v[8], v[9]); o1.y = pk2(v[10], v[11]); o1.z = pk2(v[12], v[13]); o1.w = pk2(v[14], v[15]);
                *(v4u*)(rowp + s * 16) = o0; *(v4u*)(rowp + s * 16 + 8) = o1; }
        } else {
            for (int q = 0; q < 32; ++q) { float v[8];
                const int dir = q >> 4, ri = (q >> 3) & 1, ex = dir == 0 ? t + 1 : 16 - t;
#pragma unroll
                for (int e = 0; e < 8; ++e) { const int p = 8 * (q & 7) + e; const float cr = Cc[((dir * 16 + co) * 64 + p) * 2], ci = Cc[((dir * 16 + co) * 64 + p) * 2 + 1], ar = apw[((dir * 17 + ex) * 64 + p) * 2], ai = apw[((dir * 17 + ex) * 64 + p) * 2 + 1];
                    v[e] = ri == 0 ? (cr * ar - ci * ai) : -(cr * ai + ci * ar); }
                v4u o0; o0.x = pk2(v[0], v[1]); o0.y = pk2(v[2], v[3]); o0.z = pk2(v[4], v[5]); o0.w = pk2(v[6], v[7]); *(v4u*)(rowp + q * 8) = o0; }
        }
    }
    { const int n = tid >> 1, half = tid & 1, dir = n >> 7, ri = (n >> 6) & 1, p = n & 63; bf16_t* rowp = Bpow + (size_t)n * 256 + half * 128;
        for (int s8 = 0; s8 < 8; ++s8) { const int s = 8 * half + s8, ex = dir == 0 ? 15 - s : s; const float ar = apw[((dir * 17 + ex) * 64 + p) * 2], ai = apw[((dir * 17 + ex) * 64 + p) * 2 + 1]; float v[16];
#pragma unroll
            for (int ci = 0; ci < 16; ++ci) { const float br = Bb[((dir * 64 + p) * 16 + ci) * 2], bi = Bb[((dir * 64 + p) * 16 + ci) * 2 + 1]; v[ci] = ri == 0 ? (ar * br - ai * bi) : (ar * bi + ai * br); }
            v4u o0, o1; o0.x = pk2(v[0], v[1]); o0.y = pk2(v[2], v[3]); o0.z = pk2(v[4], v[5]); o0.w = pk2(v[6], v[7]); o1.x = pk2(v[8], v[9]); o1.y = pk2(v[10], v[11]); o1.z = pk2(v[12], v[13]); o1.w = pk2(v[14], v[15]);
            *(v4u*)(rowp + s8 * 16) = o0; *(v4u*)(rowp + s8 * 16 + 8) = o1; }
    }
    __syncthreads();
}
__device__ __forceinline__ float* hrow(const Args& a, int m) { return m < MREAL ? a.out + (size_t)m * D : (float*)(a.ws + WS_HMETA) + (size_t)(m - MREAL) * D; }
__device__ __forceinline__ void write_row(const Args& a, int m, const f32x4 (&v)[4], bf16_t* ag, int lane) {
    f32x4* ho = (f32x4*)hrow(a, m) + lane;
    unsigned long long* o8 = (unsigned long long*)((bf16_t*)(a.ws + WS_HB) + (size_t)m * D) + lane;
#pragma unroll
    for (int j = 0; j < 4; ++j) { ho[64 * j] = v[j]; o8[64 * j] = pk4(v[j]); }
    if (ag && m < MVALID) {
#pragma unroll
        for (int j = 0; j < 4; ++j) { const int g = (lane >> 2) + 16 * j; *(unsigned long long*)(ag + ((size_t)g * S5R + (m >> 4)) * 512 + (m & 15) * 16 + 4 * (lane & 3)) = pk4(v[j]); }
    }
}
__device__ __forceinline__ void init_rows(const Args& a, int gw, int ngw, int lane) {
    bf16_t* ag = (bf16_t*)(a.ws + WS_AG);
    for (int m = gw; m < MVALID; m += ngw) { f32x4 v[4];
        const float* src = m < MREAL ? a.x + (size_t)m * D : a.meta + (size_t)((m - MREAL) & 15) * D;
#pragma unroll
        for (int j = 0; j < 4; ++j) v[j] = m < MVALID ? ((const f32x4*)src)[lane + 64 * j] : (f32x4){0.f, 0.f, 0.f, 0.f};
        write_row(a, m, v, ag, lane); }
}
__device__ __forceinline__ void ln_phase(const Args& a, int lnidx, bool want_ag, int gw, int ngw, int lane) {
    bf16_t* ag = want_ag ? (bf16_t*)(a.ws + WS_AG) : nullptr;
    f32x4 gn[4], bs[4];
#pragma unroll
    for (int j = 0; j < 4; ++j) { gn[j] = ((const f32x4*)(a.ln_g + (size_t)lnidx * D))[lane + 64 * j]; bs[j] = ((const f32x4*)(a.ln_b + (size_t)lnidx * D))[lane + 64 * j]; }
    for (int m = gw; m < MVALID; m += ngw) { f32x4 v[4];
        if (m < MVALID) { const f32x4* xr = (const f32x4*)hrow(a, m) + lane; float s = 0.f;
#pragma unroll
            for (int j = 0; j < 4; ++j) { v[j] = xr[64 * j]; s += (v[j].x + v[j].y) + (v[j].z + v[j].w); }
            const float mean = wave_sum(s) * (1.f / D); float s2 = 0.f;
#pragma unroll
            for (int j = 0; j < 4; ++j) { v[j] = v[j] - mean; s2 += (v[j].x * v[j].x + v[j].y * v[j].y) + (v[j].z * v[j].z + v[j].w * v[j].w); }
            const float rstd = 1.f / sqrtf(wave_sum(s2) * (1.f / D) + LN_EPS);
#pragma unroll
            for (int j = 0; j < 4; ++j) v[j] = v[j] * rstd * gn[j] + bs[j];
        } else {
#pragma unroll
            for (int j = 0; j < 4; ++j) v[j] = (f32x4){0.f, 0.f, 0.f, 0.f};
        }
        write_row(a, m, v, ag, lane); }
}
__device__ __forceinline__ void s5_scan(const Args& a, int task, int lane) {
    const int g = task >> 2, b = (task >> 1) & 1, dir = task & 1;
    const float* A16 = (const float*)(a.ws + WS_A16); const float ar = A16[((g * 2 + dir) * 64 + lane) * 2], ai = A16[((g * 2 + dir) * 64 + lane) * 2 + 1];
    const float* Sl = (const float*)(a.ws + WS_SLOC) + (size_t)g * S5R * 256 + dir * 128 + lane;
    bf16_t* Ag = (bf16_t*)(a.ws + WS_AG) + (size_t)g * S5R * 512 + 256 + dir * 128 + lane;
    float sr = 0.f, si = 0.f;
#define S5ROW(c) ((c) == 0 ? 1024 + b : 512 * b + (c) - 1)
    for (int base = 0; base < 512; base += 32) { float lr[32], li[32];
#pragma unroll
        for (int q = 0; q < 32; ++q) { const int c = dir == 0 ? base + q : 512 - (base + q); const int r = S5ROW(c); lr[q] = Sl[(size_t)r * 256]; li[q] = Sl[(size_t)r * 256 + 64]; }
#pragma unroll
        for (int q = 0; q < 32; ++q) { const int c = dir == 0 ? base + q : 512 - (base + q); const int r = S5ROW(c);
            Ag[(size_t)r * 512] = (bf16_t)f2bf(sr); Ag[(size_t)r * 512 + 64] = (bf16_t)f2bf(si);
            const float t = ar * sr - ai * si + lr[q]; si = ar * si + ai * sr + li[q]; sr = t; }
    }
    { const int c = dir == 0 ? 512 : 0; const int r = S5ROW(c); Ag[(size_t)r * 512] = (bf16_t)f2bf(sr); Ag[(size_t)r * 512 + 64] = (bf16_t)f2bf(si); }
#undef S5ROW
}

enum { T_RES, T_GLU, T_SWIGLU, T_QKV };
typedef short bf16x8_t __attribute__((ext_vector_type(8)));
template <int MODE, int K, int LDA>
__device__ __forceinline__ void tail_gemm(const bf16_t* A, const bf16_t* Bt, int N, LAS float* red, int G, int bx, int wave, int lane, const void* p0, void* p1) {
    const int fr = lane & 15, fq = lane >> 4; constexpr int KW = K / 8, NS = KW / 32; static_assert(KW % 32 == 0, "K split");
    const int ntasks = N / 16;
    for (int task = G - 1 - bx; task < ntasks; task += G) {
        const int n0 = task * 16, brow0 = (MODE == T_SWIGLU) ? ((n0 >> 7) * 256 + (n0 & 127)) : n0;
        const bf16_t* ap = A + (size_t)fr * LDA + wave * KW + 8 * fq;
        const bf16_t* bp = Bt + (size_t)(brow0 + fr) * K + wave * KW + 8 * fq;
        f32x4 acc0 = {0.f, 0.f, 0.f, 0.f}, acc1 = acc0, acc2 = acc0, acc3 = acc0;
#pragma unroll
        for (int s = 0; s < NS; ++s) {
            const bf16x8_t a0 = *(const bf16x8_t*)(ap + s * 32), a1 = *(const bf16x8_t*)(ap + (size_t)16 * LDA + s * 32), b0 = *(const bf16x8_t*)(bp + s * 32);
            acc0 = __builtin_amdgcn_mfma_f32_16x16x32_bf16(b0, a0, acc0, 0, 0, 0); acc1 = __builtin_amdgcn_mfma_f32_16x16x32_bf16(b0, a1, acc1, 0, 0, 0);
            if constexpr (MODE == T_SWIGLU) { const bf16x8_t b1 = *(const bf16x8_t*)(bp + (size_t)128 * K + s * 32);
                acc2 = __builtin_amdgcn_mfma_f32_16x16x32_bf16(b1, a0, acc2, 0, 0, 0); acc3 = __builtin_amdgcn_mfma_f32_16x16x32_bf16(b1, a1, acc3, 0, 0, 0); }
        }
        LAS f32x4* rp = (LAS f32x4*)red + (wave * 64 + lane) * 4;
        rp[0] = acc0; rp[1] = acc1; if constexpr (MODE == T_SWIGLU) { rp[2] = acc2; rp[3] = acc3; }
        __syncthreads();
        if (wave == 0) {
            f32x4 v0 = acc0, v1 = acc1, v2 = acc2, v3 = acc3;
#pragma unroll
            for (int w = 1; w < 8; ++w) { const LAS f32x4* q = (const LAS f32x4*)red + (w * 64 + lane) * 4; v0 += q[0]; v1 += q[1]; if constexpr (MODE == T_SWIGLU) { v2 += q[2]; v3 += q[3]; } }
#pragma unroll
            for (int half = 0; half < 2; ++half) { const int row = fr + 16 * half; const f32x4 v = half ? v1 : v0, u = half ? v3 : v2; const int col = n0 + 4 * fq;
                if constexpr (MODE == T_RES) { f32x4* p = (f32x4*)((float*)p1 + (size_t)row * D + col); const f32x4 hv = *p; *p = hv * DN_ALPHA + v; }
                else if constexpr (MODE == T_GLU) { const unsigned long long gv = *(const unsigned long long*)((const bf16_t*)p0 + (size_t)row * D + col); const unsigned g0 = (unsigned)gv, g1 = (unsigned)(gv >> 32);
                    f32x4 o; o.x = __uint_as_float(g0 << 16) * pg8::sigmoid_f(v.x); o.y = __uint_as_float(g0 & 0xffff0000u) * pg8::sigmoid_f(v.y); o.z = __uint_as_float(g1 << 16) * pg8::sigmoid_f(v.z); o.w = __uint_as_float(g1 & 0xffff0000u) * pg8::sigmoid_f(v.w);
                    *(unsigned long long*)((bf16_t*)p1 + (size_t)row * D + col) = pk4(o); }
                else if constexpr (MODE == T_SWIGLU) { f32x4 o; o.x = v.x * pg8::sigmoid_f(v.x) * u.x; o.y = v.y * pg8::sigmoid_f(v.y) * u.y; o.z = v.z * pg8::sigmoid_f(v.z) * u.z; o.w = v.w * pg8::sigmoid_f(v.w) * u.w;
                    *(unsigned long long*)((bf16_t*)p1 + (size_t)row * FF + col) = pk4(o); }
                else { *(unsigned long long*)((bf16_t*)p1 + (size_t)row * QKVW + col) = pk4(v); }
            }
        }
        __syncthreads();
    }
}
__device__ __forceinline__ void normrope_phase(const Args& a, int j, int gw, int ngw, int lane) {
    bf16_t* QKV = (bf16_t*)(a.ws + WS_QKV);
    const float qg = a.q_gain[j * 64 + lane] * attn_body::C2, kg = a.k_gain[j * 64 + lane];
    const int i = lane & 15, axis = lane >> 5; const float invf = exp2f(-(float)i * 0.8304820237218406f);
    const bool second = (lane >> 4) & 1;
    for (int m = gw; m < MVALID; m += ngw) {
        const int t = m & 8191; const float pos = m < MREAL ? (float)(axis ? (t & 63) : (t >> 6)) : 0.f;
        const float ang = pos * invf, cs = cosf(ang), sn = sinf(ang);
        bf16_t* row = QKV + (size_t)m * QKVW + lane; float x[20];
#pragma unroll
        for (int h = 0; h < 20; ++h) x[h] = __uint_as_float((unsigned)row[h * 64] << 16);
#pragma unroll
        for (int h = 0; h < 20; ++h) { const float ss = wave_sum(x[h] * x[h]); const float y = x[h] * (1.f / sqrtf(ss * (1.f / 64.f) + QK_EPS)) * (h < 16 ? qg : kg);
            const float o = __shfl_xor(y, 16); const float r = second ? (y * cs + o * sn) : (y * cs - o * sn); row[h * 64] = (bf16_t)f2bf(r); }
    }
    for (int m = MVALID + gw; m < MVALID + 64; m += ngw) *(v4u*)(QKV + (size_t)m * QKVW + 1024 + 8 * lane) = (v4u){0u, 0u, 0u, 0u};
}
#define XB_TMO      128
#define XB_XCNT(j)  (256  + 64 * (j))
#define XB_XSUB(j)  (1280 + 64 * (j))
#define XB_XGEN(j)  (2304 + 64 * (j))
#define XB_TOP      3328
#define XB_TOPGEN   3392
#define XCD_BAR_WORDS 3456
#define XB_SPIN_CAP (1u << 18)

__device__ __forceinline__ unsigned xb_ld(unsigned* p)              { return __hip_atomic_load(p, __ATOMIC_RELAXED, __HIP_MEMORY_SCOPE_AGENT); }
__device__ __forceinline__ unsigned xb_add(unsigned* p, unsigned v) { return __hip_atomic_fetch_add(p, v, __ATOMIC_RELAXED, __HIP_MEMORY_SCOPE_AGENT); }
__device__ __forceinline__ unsigned xb_xcc_id() { return (unsigned)__builtin_amdgcn_s_getreg((3 << 11) | 20) & 0xFu; }
#define XB_SPIN(cond, bar) do { unsigned _sp = 0; while (cond) { __builtin_amdgcn_s_sleep(1); \
    if ((++_sp & 255u) == 0u) { if (xb_ld(&(bar)[XB_TMO])) break; if (_sp > XB_SPIN_CAP) { atomicAdd(&(bar)[XB_TMO], 1u); break; } } } } while (0)

struct XcdBarrier {
    unsigned* bar; unsigned x;
    volatile LAS unsigned* st;
};

__device__ __forceinline__ XcdBarrier xcd_barrier_post(unsigned* bar, volatile LAS unsigned* st) {
    XcdBarrier b; b.bar = bar; b.x = xb_xcc_id(); b.st = st;
    if (threadIdx.x == 0) (void)xb_add(&bar[XB_XCNT(b.x)], 1u);
    return b;
}
__device__ __forceinline__ void xcd_barrier_complete(unsigned* bar, unsigned x, unsigned& nloc, unsigned& nx) {
    const unsigned G = gridDim.x * gridDim.y * gridDim.z;
    unsigned sum, cnt, mine, sp = 0u;
    for (;;) {
        sum = 0u; cnt = 0u; mine = 0u;
#pragma unroll
        for (unsigned j = 0; j < 16; ++j) { const unsigned c = xb_ld(&bar[XB_XCNT(j)]); sum += c; cnt += (c > 0u) ? 1u : 0u; mine = (j == x) ? c : mine; }
        if (sum == G) break;
        __builtin_amdgcn_s_sleep(1);
        if ((++sp & 255u) == 0u) { if (xb_ld(&bar[XB_TMO])) break; if (sp > XB_SPIN_CAP) { atomicAdd(&bar[XB_TMO], 1u); break; } }
    }
    nloc = mine > 0u ? mine : 1u; nx = cnt > 0u ? cnt : 1u;
}

__device__ __forceinline__ void xcd_barrier(const XcdBarrier& b) {
    asm volatile("s_waitcnt vmcnt(0)" ::: "memory");
    __syncthreads();
    if (threadIdx.x == 0) {
        unsigned* bar = b.bar;
        __builtin_amdgcn_s_waitcnt(0);
        unsigned nloc = b.st[0], nx = b.st[1];
        if (nloc == 0u) { xcd_barrier_complete(bar, b.x, nloc, nx); b.st[0] = nloc; b.st[1] = nx; }
        const unsigned old = xb_add(&bar[XB_XSUB(b.x)], 1u);
        const unsigned gen = old / nloc;
        if (old + 1u == (gen + 1u) * nloc) {
            __builtin_amdgcn_fence(__ATOMIC_RELEASE, "agent");
            asm volatile("s_waitcnt vmcnt(0)" ::: "memory");
            const unsigned og = xb_add(&bar[XB_TOP], 1u);
            const unsigned tg = og / nx;
            if (og + 1u == (tg + 1u) * nx) xb_add(&bar[XB_TOPGEN], 1u);
            else XB_SPIN(xb_ld(&bar[XB_TOPGEN]) == tg, bar);
            __builtin_amdgcn_fence(__ATOMIC_ACQUIRE, "agent");
            xb_add(&bar[XB_XGEN(b.x)], 1u);
            asm volatile("s_waitcnt vmcnt(0)" ::: "memory");
        } else {
            XB_SPIN(xb_ld(&bar[XB_XGEN(b.x)]) == gen, bar);
            __builtin_amdgcn_fence(__ATOMIC_ACQUIRE, "agent");
            asm volatile("s_waitcnt vmcnt(0)" ::: "memory");
        }
    }
    __syncthreads();
}
constexpr int NPH = 35;
enum { K_P0, K_S5A, K_S5B, K_S5C, K_GLU, K_RESMIX, K_LN1, K_GU, K_RESDN, K_LN2, K_QKV, K_ROPE, K_ATTN };
template <int KIND, int LAYER>
__device__ __forceinline__ void run_phase(const Args& a, unsigned char* lds, int G, int bx, int vcu) {
    int tid_ = threadIdx.x; asm volatile("" : "+v"(tid_));
    const int tid = tid_, lane = tid & 63, wave = __builtin_amdgcn_readfirstlane(tid >> 6);
    const int gw = vcu * NWAVES + wave, ngw = G * NWAVES;
    LAS unsigned char* L = (LAS unsigned char*)lds;
    unsigned char* ws = a.ws;
    float* hmeta = (float*)(ws + WS_HMETA);
    constexpr int layer = LAYER, j = LAYER >> 1; constexpr bool is_attn = LAYER & 1;
    if constexpr (KIND == K_P0) {
        convert_weights(a, 0, 0, L, gw, ngw, wave, lane);
        convert_weights(a, 2, 0, L, gw, ngw, wave, lane);
        __syncthreads();
        for (int g = bx; g < 64; g += G) s5_tables(a, 0, g, (LAS float*)L, tid);
        init_rows(a, gw, ngw, lane);
    } else if constexpr (KIND == K_S5A) {
        pg8::Gemm g{(const bf16_t*)(ws + WS_AG), (const bf16_t*)(ws + WS_BPOW), 0, 256, 256, 512};
        pg8::S5Order S{G, bx, 1024, 512}; pg8::EpiS5a E{(float*)(ws + WS_SLOC)};
        pg8::gemm_phase<pg8::EpiS5a, pg8::S5Order, true, true>(L, g, S, E);
        if constexpr (layer > 0) convert_weights(a, 2, layer, L, gw, ngw, wave, lane);
    } else if constexpr (KIND == K_S5B) {
        if (wave == 0) for (int task = bx; task < 256; task += G) s5_scan(a, task, lane);
    } else if constexpr (KIND == K_S5C) {
        pg8::Gemm g{(const bf16_t*)(ws + WS_AG), (const bf16_t*)(ws + WS_TMAT), 0, 256, 512, 512};
        pg8::S5Order S{G, bx, 1024, 1024}; pg8::EpiS5c E{a.out, hmeta, a.s5d + (size_t)j * D, (bf16_t*)(ws + WS_G)};
        pg8::gemm_phase<pg8::EpiS5c, pg8::S5Order, true, true>(L, g, S, E);
    } else if constexpr (KIND == K_GLU) {
        pg8::Gemm g{(const bf16_t*)(ws + WS_G), (const bf16_t*)(ws + WS_WMIX), MREAL, D, D, D}; pg8::StaticOrder S; S.init(MREAL, D, D, D, G, bx);
        pg8::EpiGlu E{(const bf16_t*)(ws + WS_G), (bf16_t*)(ws + WS_Z)};
        pg8::gemm_phase<pg8::EpiGlu, pg8::StaticOrder, true, true>(L, g, S, E);
        tail_gemm<T_GLU, D, D>((const bf16_t*)(ws + WS_G) + (size_t)MREAL * D, (const bf16_t*)(ws + WS_WMIX), D, (LAS float*)L, G, bx, wave, lane, (const bf16_t*)(ws + WS_G) + (size_t)MREAL * D, (bf16_t*)(ws + WS_Z) + (size_t)MREAL * D);
    } else if constexpr (KIND == K_RESMIX || KIND == K_RESDN) {
        constexpr bool dn = KIND == K_RESDN; constexpr int K = dn ? FF : D;
        const bf16_t* A = dn ? (const bf16_t*)(ws + WS_FF) : is_attn ? (const bf16_t*)(ws + WS_O) : (const bf16_t*)(ws + WS_Z);
        const bf16_t* Bt = dn ? (const bf16_t*)(ws + WS_WDN) : is_attn ? (const bf16_t*)(ws + WS_WMIX + 3 * MiB) : (const bf16_t*)(ws + WS_WMIX + 2 * MiB);
        pg8::Gemm g{A, Bt, MREAL, D, K, K}; pg8::StaticOrder S; S.init(MREAL, D, K, K, G, bx);
        pg8::EpiRes E{a.out, hmeta, DN_ALPHA};
        pg8::gemm_phase<pg8::EpiRes, pg8::StaticOrder, true, true>(L, g, S, E);
        tail_gemm<T_RES, K, K>(A + (size_t)MREAL * K, Bt, D, (LAS float*)L, G, bx, wave, lane, nullptr, hmeta);
    } else if constexpr (KIND == K_LN1 || KIND == K_LN2) {
        constexpr bool second = KIND == K_LN2;
        ln_phase(a, layer * 2 + (second ? 1 : 0), second && layer < 3 && !((layer + 1) & 1), gw, ngw, lane);
    } else if constexpr (KIND == K_GU) {
        pg8::Gemm g{(const bf16_t*)(ws + WS_HB), (const bf16_t*)(ws + WS_WGU), MREAL, 2 * FF, D, D}; pg8::StaticOrder S; S.init(MREAL, 2 * FF, D, D, G, bx);
        pg8::EpiSwiGlu E{(bf16_t*)(ws + WS_FF), FF};
        pg8::gemm_phase<pg8::EpiSwiGlu, pg8::StaticOrder, true, true>(L, g, S, E);
        tail_gemm<T_SWIGLU, D, D>((const bf16_t*)(ws + WS_HB) + (size_t)MREAL * D, (const bf16_t*)(ws + WS_WGU), FF, (LAS float*)L, G, bx, wave, lane, nullptr, (bf16_t*)(ws + WS_FF) + (size_t)MREAL * FF);
        if constexpr (layer < 3) {
            convert_weights(a, (layer + 1) & 1, (layer + 1) >> 1, L, gw, ngw, wave, lane);
            if constexpr (!((layer + 1) & 1)) { __syncthreads(); for (int g2 = bx; g2 < 64; g2 += G) s5_tables(a, (layer + 1) >> 1, g2, (LAS float*)L, tid); }
        }
    } else if constexpr (KIND == K_QKV) {
        pg8::Gemm g{(const bf16_t*)(ws + WS_HB), (const bf16_t*)(ws + WS_WMIX), MREAL, QKVW, D, D}; pg8::StaticOrder S; S.init(MREAL, QKVW, D, D, G, bx);
        pg8::EpiBf16<0> E{(bf16_t*)(ws + WS_QKV), QKVW, nullptr, 0, 0, 1.f};
        pg8::gemm_phase<pg8::EpiBf16<0>, pg8::StaticOrder, true, true>(L, g, S, E);
        tail_gemm<T_QKV, D, D>((const bf16_t*)(ws + WS_HB) + (size_t)MREAL * D, (const bf16_t*)(ws + WS_WMIX), QKVW, (LAS float*)L, G, bx, wave, lane, nullptr, (bf16_t*)(ws + WS_QKV) + (size_t)MREAL * QKVW);
        convert_weights(a, 2, layer, L, gw, ngw, wave, lane);
    } else if constexpr (KIND == K_ROPE) {
        normrope_phase(a, j, gw, ngw, lane);
    } else if constexpr (KIND == K_ATTN) {
        const attn_body::bf16* QKV = (const attn_body::bf16*)(ws + WS_QKV); attn_body::bf16* O = (attn_body::bf16*)(ws + WS_O);
        if (G == 256) {
#pragma unroll 1
            for (int i = 0; i < 5; ++i) {
                int b, h, nvalid; long rows0;
                if (i < 4) { const int bh = vcu >> 3; b = bh >> 4; h = bh & 15; rows0 = (long)b * 8192 + ((vcu & 7) * 4 + i) * 256; nvalid = 256; }
                else { if (vcu >= 32 || LAYER == 3) break;     b = vcu >> 4; h = vcu & 15; rows0 = MREAL + 16 * b; nvalid = 16; }
                const attn_body::bf16* Kh = QKV + (long)b * 8192 * attn_body::PQ + 1024 + (h >> 2) * 64;
                attn_body::attn_unit<8>(QKV + rows0 * attn_body::PQ + h * 64, Kh, Kh + 256, (long)(MREAL + 16 * b - 8192 * b), O + rows0 * attn_body::PO + h * 64, nvalid, (char*)lds);
            }
        }
    }
}
__global__ void __launch_bounds__(NTHREADS, 2) mk_fwd(Args a) {
    extern __shared__ __attribute__((aligned(16))) unsigned char lds[];
    cg::grid_group grid = cg::this_grid();
    const int G = gridDim.x, bx = blockIdx.x, vcu = (G % 8 == 0) ? (bx % 8) * (G / 8) + bx / 8 : bx;
    const int lo = a.ph_lo, hi = a.ph_hi;
    volatile LAS unsigned* bst = (volatile LAS unsigned*)((LAS unsigned char*)lds + 139264);
    if (threadIdx.x < 2) bst[threadIdx.x] = 0u;
    __syncthreads();
    const XcdBarrier bar = xcd_barrier_post((unsigned*)a.ws + 4096, bst);
#define PH(k, KIND, LAYER) if (lo <= (k) && (k) < hi) { run_phase<KIND, LAYER>(a, lds, G, bx, vcu); if ((k) + 1 < hi) { if ((k) == 0) grid.sync(); else xcd_barrier(bar); } }
#define S5LAYER(k0, LY) PH(k0, K_S5A, LY) PH(k0 + 1, K_S5B, LY) PH(k0 + 2, K_S5C, LY) PH(k0 + 3, K_GLU, LY) PH(k0 + 4, K_RESMIX, LY) PH(k0 + 5, K_LN1, LY) PH(k0 + 6, K_GU, LY) PH(k0 + 7, K_RESDN, LY) PH(k0 + 8, K_LN2, LY)
#define ATLAYER(k0, LY) PH(k0, K_QKV, LY) PH(k0 + 1, K_ROPE, LY) PH(k0 + 2, K_ATTN, LY) PH(k0 + 3, K_RESMIX, LY) PH(k0 + 4, K_LN1, LY) PH(k0 + 5, K_GU, LY) PH(k0 + 6, K_RESDN, LY) PH(k0 + 7, K_LN2, LY)
    PH(0, K_P0, 0)
    S5LAYER(1, 0)
    ATLAYER(10, 1)
    S5LAYER(18, 2)
    ATLAYER(27, 3)
#undef PH
}

extern "C" void kernel_launch(void* const* d_in, const int* in_sizes, int n_in, void* d_out, int out_size, void* d_ws, size_t ws_size, hipStream_t stream) {
    static int grid = 0;
    if (grid == 0) {
        int dev = 0, cus = 0, per_cu = 0;
        if (n_in != 21 || out_size != MREAL * D || ws_size < WS_END) { fprintf(stderr, "kernel_launch: unexpected shapes (n_in %d out %d ws %zu)\n", n_in, out_size, ws_size); grid = -1; return; }
        hipGetDevice(&dev); hipDeviceGetAttribute(&cus, hipDeviceAttributeMultiprocessorCount, dev);
        hipFuncSetAttribute((const void*)mk_fwd, hipFuncAttributeMaxDynamicSharedMemorySize, LDS_BYTES);
        hipOccupancyMaxActiveBlocksPerMultiprocessor(&per_cu, (const void*)mk_fwd, NTHREADS, LDS_BYTES);
        (void)hipGetLastError();
        grid = cus * (per_cu >= 1 ? 1 : 1);
        if (grid != 256) fprintf(stderr, "kernel_launch: grid %d (expected 256)\n", grid);
    }
    if (grid < 0) return;
    if (hipMemsetAsync(d_ws, 0, 65536, stream) != hipSuccess) { fprintf(stderr, "kernel_launch: memset failed\n"); return; }
    Args a{};
    const float** p = (const float**)&a;
    for (int i = 0; i < 21; ++i) p[i] = (const float*)d_in[i];
    a.out = (float*)d_out; a.ws = (unsigned char*)d_ws; a.ph_lo = 0; a.ph_hi = NPH;
    void* args[] = {&a};
    hipError_t e = hipLaunchCooperativeKernel((const void*)mk_fwd, dim3(grid), dim3(NTHREADS), args, LDS_BYTES, stream);
    if (e != hipSuccess) fprintf(stderr, "cooperative launch failed: %s (grid %d)\n", hipGetErrorString(e), grid);
}
```
